# Optimizing an MI355X kernel written in HIP

```python
import jax
import jax.numpy as jnp
from jax import lax
import numpy as np

D_MODEL = 2048
BATCH = 4
SEQ = 2048
DEPTH = 4

N_MIXERS = 4
HEAD_DIM = 128
N_HEADS = 16
MIX_WIDTH = N_HEADS * HEAD_DIM
N_MEM = 256
MEM_HEADS = 4
MEM_WIDTH = MEM_HEADS * HEAD_DIM
BLOCK = 128
ROPE_THETA = 10000.0
EPS = 1e-6
IDX_HEADS = 16
IDX_DIM = 64
TOPK_MAX = 256
DILATED_PAIRS = ((128, 1), (512, 4), (2048, 16))
N_DIL_GROUPS = len(DILATED_PAIRS)
DIL_HEADS = 6
DIL_WIDTH = DIL_HEADS * HEAD_DIM
Q_LORA = 512
KV_LORA = 512
QK_NOPE = 128
QK_ROPE = 64
V_HEAD = 128

A_SIZES = (MIX_WIDTH, MIX_WIDTH, MIX_WIDTH, N_HEADS, MEM_WIDTH, MIX_WIDTH + MEM_WIDTH)
B_SIZES = (MIX_WIDTH, HEAD_DIM, HEAD_DIM, IDX_HEADS * IDX_DIM, IDX_DIM, IDX_HEADS, MEM_WIDTH, MIX_WIDTH + MEM_WIDTH)
C_SIZES = (N_DIL_GROUPS * DIL_WIDTH, N_DIL_GROUPS * DIL_WIDTH, N_DIL_GROUPS * DIL_WIDTH, MEM_WIDTH, DIL_WIDTH + MEM_WIDTH)
D_SIZES = (Q_LORA, KV_LORA, QK_ROPE, MEM_WIDTH, N_HEADS * V_HEAD + MEM_WIDTH)

F32 = jnp.float32

kernel_name = 'hybrid_fox_dsa_dilated_mla_block'


def rms_norm(x, g):
    x32 = x.astype(F32)
    y = x32 * lax.rsqrt(jnp.mean(x32 * x32, axis=-1, keepdims=True) + EPS)
    return y.astype(x.dtype) * g


def rope(x, pos):
    dh = x.shape[-1]
    half = dh // 2
    inv_freq = jnp.power(ROPE_THETA, -jnp.arange(half, dtype=F32) * 2.0 / dh)
    ang = pos.astype(F32)[:, :, None, None] * inv_freq
    cos, sin = jnp.cos(ang), jnp.sin(ang)
    x32 = x.astype(F32)
    x1, x2 = x32[..., :half], x32[..., half:]
    return jnp.concatenate([x1 * cos - x2 * sin, x2 * cos + x1 * sin], axis=-1).astype(x.dtype)


def split_cols(u, sizes):
    bounds = []
    acc = 0
    for s in sizes[:-1]:
        acc += s
        bounds.append(acc)
    return jnp.split(u, bounds, axis=-1)


def to_blocks(a):
    b, s = a.shape[:2]
    return jnp.moveaxis(a.reshape(b, s // BLOCK, BLOCK, *a.shape[2:]), 1, 0)


def from_blocks(a):
    nb, b, blk = a.shape[:3]
    return jnp.moveaxis(a, 0, 1).reshape(b, nb * blk, *a.shape[3:])


def masked_softmax(logits, mask):
    return jax.nn.softmax(jnp.where(mask, logits, -jnp.inf), axis=-1)


def forgetting_attention(q, k, v, log_f):
    s_len, dh = q.shape[1], q.shape[-1]
    c = jnp.cumsum(log_f, axis=1)
    c_keys = jnp.moveaxis(c, 1, 2)[:, :, None, :]
    kpos = jnp.arange(s_len)
    scale = dh ** -0.5

    def block(args):
        qb, cb, i = args
        qpos = i * BLOCK + jnp.arange(BLOCK)
        s = jnp.einsum('bqhd,bkhd->bhqk', qb, k).astype(F32) * scale
        s = s + jnp.moveaxis(cb, 1, 2)[..., None] - c_keys
        p = masked_softmax(s, kpos[None, :] <= qpos[:, None])
        return jnp.einsum('bhqk,bkhd->bqhd', p.astype(v.dtype), v)

    out = lax.map(block, (to_blocks(q), to_blocks(c), jnp.arange(s_len // BLOCK)))
    return from_blocks(out)


def dsa_attention(q, k, v, q_idx, k_idx, w_idx):
    s_len, dh = q.shape[1], q.shape[-1]
    n_sel = min(TOPK_MAX, s_len // 4)
    scale = dh ** -0.5
    idx_scale = (IDX_DIM ** -0.5) * (IDX_HEADS ** -0.5)
    kpos = jnp.arange(s_len)
    gather = jax.vmap(lambda a, i: a[i])

    def block(args):
        qb, qib, wb, i = args
        qpos = i * BLOCK + jnp.arange(BLOCK)
        rel = jax.nn.relu(jnp.einsum('bqhd,bsd->bqhs', qib, k_idx).astype(F32))
        score = jnp.einsum('bqh,bqhs->bqs', wb.astype(F32), rel) * idx_scale
        score = jnp.where(kpos[None, None, :] <= qpos[None, :, None], score, -jnp.inf)
        _, sel = lax.top_k(score, n_sel)
        valid = sel <= qpos[None, :, None]
        kg = gather(k, sel)
        vg = gather(v, sel)
        s = jnp.einsum('bqhd,bqjd->bhqj', qb, kg).astype(F32) * scale
        p = masked_softmax(s, valid[:, None])
        return jnp.einsum('bhqj,bqjd->bqhd', p.astype(v.dtype), vg)

    out = lax.map(block, (to_blocks(q), to_blocks(q_idx), to_blocks(w_idx), jnp.arange(s_len // BLOCK)))
    return from_blocks(out)


def dilated_attention(q, k, v):
    s_len, dh = q.shape[1], q.shape[-1]
    scale = dh ** -0.5
    k_groups = [k[:, :, g] for g in range(N_DIL_GROUPS)]
    v_groups = [v[:, :, g] for g in range(N_DIL_GROUPS)]

    def block(args):
        qb, i = args
        qpos = i * BLOCK + jnp.arange(BLOCK)
        outs, lses = [], []
        for g, (window, dil) in enumerate(DILATED_PAIRS):
            offs = jnp.arange(window // dil + 1) * dil
            kpos = qpos[:, None] - offs[None, :]
            valid = kpos >= 0
            kidx = jnp.maximum(kpos, 0)
            kg = jnp.take(k_groups[g], kidx, axis=1)
            vg = jnp.take(v_groups[g], kidx, axis=1)
            s = jnp.einsum('bqhd,bqjhd->bhqj', qb[:, :, g], kg).astype(F32) * scale
            s = jnp.where(valid, s, -jnp.inf)
            lse = jax.nn.logsumexp(s, axis=-1, keepdims=True)
            p = jnp.exp(s - lse)
            outs.append(jnp.einsum('bhqj,bqjhd->bqhd', p.astype(v.dtype), vg))
            lses.append(jnp.moveaxis(lse[..., 0], 1, 2))
        alpha = jax.nn.softmax(jnp.stack(lses, axis=-1), axis=-1)
        o = jnp.stack(outs, axis=-1).astype(F32)
        return jnp.einsum('bqhdg,bqhg->bqhd', o, alpha).astype(v.dtype)

    out = lax.map(block, (to_blocks(q), jnp.arange(s_len // BLOCK)))
    return from_blocks(out)


def mla_attention(q_nope, q_rope, k_nope, k_rope, v):
    s_len = q_nope.shape[1]
    scale = (QK_NOPE + QK_ROPE) ** -0.5
    kpos = jnp.arange(s_len)

    def block(args):
        qn, qr, i = args
        qpos = i * BLOCK + jnp.arange(BLOCK)
        s = (jnp.einsum('bqhd,bkhd->bhqk', qn, k_nope)
             + jnp.einsum('bqhr,bkr->bhqk', qr, k_rope)).astype(F32) * scale
        p = masked_softmax(s, kpos[None, :] <= qpos[:, None])
        return jnp.einsum('bhqk,bkhd->bqhd', p.astype(v.dtype), v)

    out = lax.map(block, (to_blocks(q_nope), to_blocks(q_rope), jnp.arange(s_len // BLOCK)))
    return from_blocks(out)


def memory_attention(q_mem, mem_k, mem_v):
    s = jnp.einsum('bqhd,bnhd->bhqn', q_mem, mem_k).astype(F32) * HEAD_DIM ** -0.5
    p = jax.nn.softmax(s, axis=-1).astype(mem_v.dtype)
    return jnp.einsum('bhqn,bnhd->bqhd', p, mem_v)


def forgetting_mixer(h, pos, w_in, forget_bias):
    b, s, _ = h.shape
    q, k, v, f, q_mem, z = split_cols(h @ w_in, A_SIZES)
    log_f = jax.nn.log_sigmoid(f.astype(F32) + forget_bias.astype(F32))
    hs = (b, s, N_HEADS, HEAD_DIM)
    y = forgetting_attention(q.reshape(hs), k.reshape(hs), v.reshape(hs), log_f)
    return y.reshape(b, s, MIX_WIDTH), q_mem, z


def dsa_mixer(h, pos, w_in):
    b, s, _ = h.shape
    q, k, v, q_idx, k_idx, w_idx, q_mem, z = split_cols(h @ w_in, B_SIZES)
    q = rope(q.reshape(b, s, N_HEADS, HEAD_DIM), pos)
    k = rope(k[:, :, None, :], pos)[:, :, 0]
    q_idx = rope(q_idx.reshape(b, s, IDX_HEADS, IDX_DIM), pos)
    k_idx = rope(k_idx[:, :, None, :], pos)[:, :, 0]
    y = dsa_attention(q, k, v, q_idx, k_idx, w_idx)
    return y.reshape(b, s, MIX_WIDTH), q_mem, z


def dilated_mixer(h, pos, w_in):
    b, s, _ = h.shape
    q, k, v, q_mem, z = split_cols(h @ w_in, C_SIZES)
    flat = (b, s, N_DIL_GROUPS * DIL_HEADS, HEAD_DIM)
    grp = (b, s, N_DIL_GROUPS, DIL_HEADS, HEAD_DIM)
    q = rope(q.reshape(flat), pos).reshape(grp)
    k = rope(k.reshape(flat), pos).reshape(grp)
    y = dilated_attention(q, k, v.reshape(grp))
    return y.reshape(b, s, DIL_WIDTH), q_mem, z


def mla_mixer(h, pos, w_in, q_norm, w_uq, kv_norm, w_ukv):
    b, s, _ = h.shape
    c_q, c_kv, k_rope, q_mem, z = split_cols(h @ w_in, D_SIZES)
    qf = (rms_norm(c_q, q_norm) @ w_uq).reshape(b, s, N_HEADS, QK_NOPE + QK_ROPE)
    q_nope, q_rope = qf[..., :QK_NOPE], rope(qf[..., QK_NOPE:], pos)
    kvf = (rms_norm(c_kv, kv_norm) @ w_ukv).reshape(b, s, N_HEADS, QK_NOPE + V_HEAD)
    k_nope, v = kvf[..., :QK_NOPE], kvf[..., QK_NOPE:]
    k_rope = rope(k_rope[:, :, None, :], pos)[:, :, 0]
    y = mla_attention(q_nope, q_rope, k_nope, k_rope, v)
    return y.reshape(b, s, N_HEADS * V_HEAD), q_mem, z


def hybrid_layer(x, mem, norm_g, mem_norm_g, w_mem_kv, w_out, mixer):
    b, s, _ = x.shape
    y, q_mem, z = mixer(rms_norm(x, norm_g))
    kv = (rms_norm(mem, mem_norm_g) @ w_mem_kv).reshape(b, mem.shape[1], 2, MEM_HEADS, HEAD_DIM)
    y_mem = memory_attention(q_mem.reshape(b, s, MEM_HEADS, HEAD_DIM), kv[:, :, 0], kv[:, :, 1])
    gated = jnp.concatenate([y, y_mem.reshape(b, s, MEM_WIDTH)], axis=-1) * jax.nn.silu(z)
    return x + gated @ w_out


def setup_inputs(seed: int = 0) -> dict:
    key = jax.random.key(seed)
    keys = iter(jax.random.split(key, 64))

    def normal(shape, scale):
        return jax.random.normal(next(keys), shape, jnp.float32) * scale

    def gain(n):
        return 1.0 + 0.02 * jax.random.normal(next(keys), (n,), jnp.float32)

    def w_out(width):
        return normal((width, D_MODEL), 0.5 * width ** -0.5)

    s_in = D_MODEL ** -0.5
    inputs = {}
    inputs['x'] = normal((BATCH, SEQ, D_MODEL), 1.0)
    inputs['mem'] = normal((BATCH, N_MEM, D_MODEL), 1.0)
    inputs['positions'] = (jax.random.randint(next(keys), (BATCH, 1), 0, 1024, dtype=jnp.int32)
                           + jnp.arange(SEQ, dtype=jnp.int32)[None, :])
    inputs['l0_norm'] = gain(D_MODEL)
    inputs['l0_w_in'] = jnp.concatenate([
        normal((D_MODEL, 3 * MIX_WIDTH), s_in),
        normal((D_MODEL, N_HEADS), 0.1 * s_in),
        normal((D_MODEL, MEM_WIDTH + MIX_WIDTH + MEM_WIDTH), s_in)], axis=1)
    inputs['l0_forget_bias'] = 3.0 + 0.5 * jax.random.normal(next(keys), (N_HEADS,), jnp.float32)
    inputs['l0_mem_norm'] = gain(D_MODEL)
    inputs['l0_w_mem_kv'] = normal((D_MODEL, 2 * MEM_WIDTH), s_in)
    inputs['l0_w_out'] = w_out(MIX_WIDTH + MEM_WIDTH)
    inputs['l1_norm'] = gain(D_MODEL)
    inputs['l1_w_in'] = normal((D_MODEL, sum(B_SIZES)), s_in)
    inputs['l1_mem_norm'] = gain(D_MODEL)
    inputs['l1_w_mem_kv'] = normal((D_MODEL, 2 * MEM_WIDTH), s_in)
    inputs['l1_w_out'] = w_out(MIX_WIDTH + MEM_WIDTH)
    inputs['l2_norm'] = gain(D_MODEL)
    inputs['l2_w_in'] = normal((D_MODEL, sum(C_SIZES)), s_in)
    inputs['l2_mem_norm'] = gain(D_MODEL)
    inputs['l2_w_mem_kv'] = normal((D_MODEL, 2 * MEM_WIDTH), s_in)
    inputs['l2_w_out'] = w_out(DIL_WIDTH + MEM_WIDTH)
    inputs['l3_norm'] = gain(D_MODEL)
    inputs['l3_w_in'] = normal((D_MODEL, sum(D_SIZES)), s_in)
    inputs['l3_q_norm'] = gain(Q_LORA)
    inputs['l3_w_uq'] = normal((Q_LORA, N_HEADS * (QK_NOPE + QK_ROPE)), Q_LORA ** -0.5)
    inputs['l3_kv_norm'] = gain(KV_LORA)
    inputs['l3_w_ukv'] = normal((KV_LORA, N_HEADS * (QK_NOPE + V_HEAD)), KV_LORA ** -0.5)
    inputs['l3_mem_norm'] = gain(D_MODEL)
    inputs['l3_w_mem_kv'] = normal((D_MODEL, 2 * MEM_WIDTH), s_in)
    inputs['l3_w_out'] = w_out(N_HEADS * V_HEAD + MEM_WIDTH)
    inputs['final_norm'] = gain(D_MODEL)
    return inputs


def reference(x, mem, positions,
              l0_norm, l0_w_in, l0_forget_bias, l0_mem_norm, l0_w_mem_kv, l0_w_out,
              l1_norm, l1_w_in, l1_mem_norm, l1_w_mem_kv, l1_w_out,
              l2_norm, l2_w_in, l2_mem_norm, l2_w_mem_kv, l2_w_out,
              l3_norm, l3_w_in, l3_q_norm, l3_w_uq, l3_kv_norm, l3_w_ukv, l3_mem_norm, l3_w_mem_kv, l3_w_out,
              final_norm):
    mixers = (
        lambda h: forgetting_mixer(h, positions, l0_w_in, l0_forget_bias),
        lambda h: dsa_mixer(h, positions, l1_w_in),
        lambda h: dilated_mixer(h, positions, l2_w_in),
        lambda h: mla_mixer(h, positions, l3_w_in, l3_q_norm, l3_w_uq, l3_kv_norm, l3_w_ukv),
    )
    layer_params = (
        (l0_norm, l0_mem_norm, l0_w_mem_kv, l0_w_out),
        (l1_norm, l1_mem_norm, l1_w_mem_kv, l1_w_out),
        (l2_norm, l2_mem_norm, l2_w_mem_kv, l2_w_out),
        (l3_norm, l3_mem_norm, l3_w_mem_kv, l3_w_out),
    )
    for i in range(DEPTH):
        norm_g, mem_g, w_mem_kv, w_out = layer_params[i]
        x = hybrid_layer(x, mem, norm_g, mem_g, w_mem_kv, w_out, mixers[i % N_MIXERS])
    return rms_norm(x, final_norm)
```

```cpp
#include <hip/hip_runtime.h>
#include <hip/hip_cooperative_groups.h>
#include <cstdio>
#include <cstdint>
namespace cg = cooperative_groups;

#define LAS __attribute__((address_space(3)))
typedef unsigned short bf16_t;
typedef short bf16x8 __attribute__((ext_vector_type(8)));
typedef short s16x4 __attribute__((ext_vector_type(4)));
typedef float f32x4 __attribute__((ext_vector_type(4)));
typedef float f32x16 __attribute__((ext_vector_type(16)));
typedef unsigned u32x4 __attribute__((ext_vector_type(4)));

constexpr int NB = 4, SEQ = 2048, NTOK = NB * SEQ, DM = 2048;
constexpr int LDS_BYTES = 160 * 1024;
constexpr float LOG2E = 1.4426950408889634f;
#ifndef REP_SYNC
#define REP_SYNC 1
#endif
#ifndef REP_ATTN
#define REP_ATTN 1
#endif
#ifndef REP_GEMM
#define REP_GEMM 1
#endif
#ifndef REP_PREP
#define REP_PREP 1
#endif
#ifndef REP_ATTN_L
#define REP_ATTN_L 9
#endif
#ifndef REP_UQ
#define REP_UQ 1
#endif
#ifndef REP_IDX
#define REP_IDX 1
#endif
#define GSYNC() do { for (int _r = 0; _r < REP_SYNC; ++_r) xcd_barrier(xbar); } while (0)

constexpr size_t WT_IN_BYTES = (size_t)9472 * 2048 * 2, WT_OUT_BYTES = (size_t)2048 * 2560 * 2;
constexpr size_t WS_WT_IN = 0;
constexpr size_t WS_WT_OUT = WS_WT_IN + 2 * WT_IN_BYTES;
constexpr size_t WS_WT_UQ = WS_WT_OUT + 2 * WT_OUT_BYTES;
constexpr size_t WS_WT_UKV = WS_WT_UQ + (size_t)3072 * 512 * 2;
constexpr size_t WS_WT_MKV = WS_WT_UKV + (size_t)4096 * 512 * 2;
constexpr size_t WS_HG = WS_WT_MKV + (size_t)4096 * 2048 * 2;
constexpr size_t WS_U = WS_HG + (size_t)NTOK * 2560 * 2;
constexpr size_t U3_BYTES = (size_t)NTOK * 4352 * 2, Q3_BYTES = (size_t)NTOK * 3072 * 2, KV3_BYTES = (size_t)NTOK * 4096 * 2;
constexpr size_t WS_Q3 = WS_U + U3_BYTES;
constexpr size_t WS_KV3 = WS_Q3 + Q3_BYTES;
constexpr size_t WS_MEMN = WS_KV3 + KV3_BYTES;
constexpr size_t WS_MKV = WS_MEMN + (size_t)1024 * 2048 * 2;
constexpr size_t WS_CQ = WS_MKV + (size_t)1024 * 4096 * 2;
constexpr size_t WS_CKV = WS_CQ + (size_t)NTOK * 512 * 2;
constexpr size_t WS_MASK = WS_CKV + (size_t)NTOK * 512 * 2;
constexpr size_t WS_CS128 = WS_MASK + (size_t)NTOK * 64 * 4;
constexpr size_t WS_CS64 = WS_CS128 + (size_t)NTOK * 64 * 8;
constexpr size_t WS_SSQ = WS_CS64 + (size_t)NTOK * 32 * 8;
constexpr size_t WS_BAR = WS_SSQ + (size_t)NTOK * 4;
constexpr size_t BAR_BYTES = 16384;
constexpr size_t WS_END = WS_BAR + BAR_BYTES;
static_assert(WS_U + (size_t)NTOK * 9472 * 2 <= WS_MEMN, "U0 must fit the U region");
constexpr size_t WS_HB = WS_U + (size_t)144 * 1024 * 1024;
static_assert(WS_HB + (size_t)NTOK * 2048 * 2 <= WS_MEMN && (size_t)NTOK * 8704 * 2 <= (size_t)144 * 1024 * 1024, "HB placement");

struct Params {
    const float* in[32];
    float* out;
    unsigned char* ws;
};

__device__ __forceinline__ int otid() { int t = threadIdx.x; asm volatile("" : "+v"(t)); return t; }
__device__ __forceinline__ float bf2f(short s) { return __uint_as_float(((unsigned)(unsigned short)s) << 16); }
__device__ __forceinline__ float bfu2f(bf16_t s) { return __uint_as_float(((unsigned)s) << 16); }
__device__ __forceinline__ unsigned cvtpk(float lo, float hi) { unsigned r; asm volatile("v_cvt_pk_bf16_f32 %0, %1, %2" : "=v"(r) : "v"(lo), "v"(hi)); return r; }
__device__ __forceinline__ bf16_t f2bf(float f) { return (bf16_t)(cvtpk(f, f) & 0xffffu); }
__device__ __forceinline__ bf16x8 pack8(const float* a) { u32x4 w = {cvtpk(a[0], a[1]), cvtpk(a[2], a[3]), cvtpk(a[4], a[5]), cvtpk(a[6], a[7])}; return __builtin_bit_cast(bf16x8, w); }

namespace pg8 {
constexpr int BM = 256, BK = 64, HALF = 128, HTB = HALF * BK * 2, STAGE_BYTES = 8 * HTB, NXCD = 8, WGM = 8;
__device__ __forceinline__ int lds_byte(int r, int c) { const int st = (r >> 4) * 2 + (c >> 5), rr = r & 15, cc = c & 31, ob = rr * 64 + cc * 2; return st * 1024 + (ob ^ (((ob >> 9) & 1) << 5)); }
__device__ __forceinline__ void stage_rc(int b, int& R, int& C) { const int st = b / 1024, sb = b % 1024, swz = sb ^ (((sb >> 9) & 1) << 5); R = (st >> 1) * 16 + swz / 64; C = (st & 1) * 32 + (swz % 64) / 2; }
__device__ __forceinline__ int perm32(int rho) { const int n = rho >> 4, i = rho & 15; return 8 * (i >> 2) + 4 * n + (i & 3); }
struct Unit { int pm, pn; };
struct Gemm { const bf16_t* A; const bf16_t* Bt; int M, N, K; };
struct StaticOrder {
    int nM, nN, nwg, G, c;
    __device__ void init(int M, int N, int G_, int c_) { nM = M / BM; nN = N / BM; nwg = nM * nN; G = G_; c = c_; }
    __device__ bool next(int i, Unit& u) const {
        const long L = (long)i * G + c; if (L >= nwg) return false;
        int wgid = (int)L; { const int q = nwg / NXCD, r = nwg % NXCD, xcd = wgid % NXCD, off = wgid / NXCD; wgid = (xcd < r ? xcd * (q + 1) : r * (q + 1) + (xcd - r) * q) + off; }
        const int nig = WGM * nN, gid = wgid / nig, fm = gid * WGM, gsz = (nM - fm) < WGM ? (nM - fm) : WGM;
        u.pm = fm + ((wgid % nig) % gsz); u.pn = (wgid % nig) / gsz; return true;
    }
};
struct EpiBf16 {
    static constexpr bool PERM = true;
    __device__ __forceinline__ void preload(float (&pre)[8], const Unit& u, int wr, int fr) const {
        const int row0 = u.pm * BM + wr * 64 + fr;
#pragma unroll
        for (int ai = 0; ai < 2; ++ai)
#pragma unroll
            for (int m = 0; m < 4; ++m) pre[ai * 4 + m] = ssq ? ssq[row0 + ai * HALF + m * 16] : 0.f; }
    bf16_t* O; int ldc; const float* ssq;
    __device__ __forceinline__ void operator()(const f32x4 (&acc)[2][2][4][2], const Unit& u, int wr, int wc, int fr, int fq, const float (&pre)[8]) const {
        const int row0 = u.pm * BM + wr * 64 + fr, col0 = u.pn * BM + wc * 32 + 8 * fq;
        float rsv[2][4];
#pragma unroll
        for (int ai = 0; ai < 2; ++ai)
#pragma unroll
            for (int m = 0; m < 4; ++m) rsv[ai][m] = pre[ai * 4 + m];
#pragma unroll
        for (int ai = 0; ai < 2; ++ai)
#pragma unroll
            for (int m = 0; m < 4; ++m) { const int row = row0 + ai * HALF + m * 16; bf16_t* rowp = O + (size_t)row * ldc + col0;
                const float rs = ssq ? rsqrtf(rsv[ai][m] * (1.0f / DM) + 1e-6f) : 1.0f;
#pragma unroll
                for (int bj = 0; bj < 2; ++bj) { const f32x4 v0 = acc[ai][bj][m][0] * rs, v1 = acc[ai][bj][m][1] * rs;
                    u32x4 w = {cvtpk(v0[0], v0[1]), cvtpk(v0[2], v0[3]), cvtpk(v1[0], v1[1]), cvtpk(v1[2], v1[3])};
                    *(u32x4*)(rowp + bj * HALF) = w; } }
    }
};
struct EpiResid {
    static constexpr bool PERM = false;
    const float* xin; float* xout; bf16_t* hout; float* ssq;
    __device__ __forceinline__ void preload(float (&)[8], const Unit&, int, int) const {}
    __device__ __forceinline__ void operator()(const f32x4 (&acc)[2][2][4][2], const Unit& u, int wr, int wc, int fr, int fq, const float (&)[8]) const {
        const int row0 = u.pm * BM + wr * 64 + fr, col0 = u.pn * BM + wc * 32 + 4 * fq;
        f32x4 xa[8], xb[8];
#define ER_LOAD(X, b) do { _Pragma("unroll") for (int mm = 0; mm < 2; ++mm) _Pragma("unroll") for (int q = 0; q < 4; ++q) \
            X[mm * 4 + q] = *(const f32x4*)(xin + (size_t)(row0 + ((b) >> 1) * HALF + (((b) & 1) * 2 + mm) * 16) * DM + col0 + (q >> 1) * HALF + (q & 1) * 16); } while (0)
#define ER_STORE(X, b) do { _Pragma("unroll") for (int mm = 0; mm < 2; ++mm) { const int ai = (b) >> 1, m = ((b) & 1) * 2 + mm; const int row = row0 + ai * HALF + m * 16; float ss = 0.f; \
            _Pragma("unroll") for (int q = 0; q < 4; ++q) { const size_t idx = (size_t)row * DM + col0 + (q >> 1) * HALF + (q & 1) * 16; const f32x4 x = X[mm * 4 + q] + acc[ai][q >> 1][m][q & 1]; \
                *(f32x4*)(xout + idx) = x; ss += x[0] * x[0] + x[1] * x[1] + x[2] * x[2] + x[3] * x[3]; \
                uint2 hw = make_uint2(cvtpk(x[0], x[1]), cvtpk(x[2], x[3])); *(uint2*)(hout + idx) = hw; } \
            ss += __shfl_xor(ss, 16); ss += __shfl_xor(ss, 32); if (fq == 0) atomicAdd(ssq + row, ss); } } while (0)
        ER_LOAD(xa, 0);
        ER_LOAD(xb, 1); ER_STORE(xa, 0);
        ER_LOAD(xa, 2); ER_STORE(xb, 1);
        ER_LOAD(xb, 3); ER_STORE(xa, 2);
        ER_STORE(xb, 3);
#undef ER_LOAD
#undef ER_STORE
    }
};

template <class Epi>
__device__ __forceinline__ void gemm_phase(LAS unsigned char* lds, const Gemm g, const StaticOrder& S, const Epi& E) {
    const int tid = otid(), wid = __builtin_amdgcn_readfirstlane(tid >> 6), lane = tid & 63, wr = wid >> 2, wc = wid & 3, fr = lane & 15, fq = lane >> 4;
    const int K = g.K, nt = K / BK;
    unsigned voffA[2], voffB[2];
#pragma unroll
    for (int i = 0; i < 2; ++i) { int R, C; stage_rc(tid * 16 + i * 8192, R, C); const int Rb = Epi::PERM ? ((R & ~31) + perm32(R & 31)) : R;
        voffA[i] = (unsigned)(R * K + C) * 2u; voffB[i] = (unsigned)(Rb * K + C) * 2u; }
    const size_t kstep = (size_t)(BK * 2);
    const size_t hstep = (size_t)HALF * K * 2;
    const size_t tstep = 2 * hstep;
    const unsigned ldsw = (unsigned)wid * 1024u;
    const int aoff = lds_byte(wr * 64 + fr, fq * 8), boff = lds_byte(wc * 32 + fr, fq * 8);
#define PG8_SA(b, h) (((b) * 2 + (h)) * HTB)
#define PG8_SB(b, h) ((4 + (b) * 2 + (h)) * HTB)
#define PG8_STAGE(bufoff, gbase, voff) do { _Pragma("unroll") for (int _i = 0; _i < 2; ++_i) \
        __builtin_amdgcn_global_load_lds((const unsigned*)((const char*)(gbase) + (voff)[_i]), (LAS unsigned*)(lds + (bufoff) + ldsw + _i * 8192), 16, 0, 0); } while (0)
#define PG8_LDA(dst, b, h) do { _Pragma("unroll") for (int m = 0; m < 4; ++m) _Pragma("unroll") for (int k = 0; k < 2; ++k) dst[m][k] = *(const LAS bf16x8*)(lds + PG8_SA(b, h) + aoff + m * 2048 + k * 1024); } while (0)
#define PG8_LDB(dst, b, h) do { _Pragma("unroll") for (int n = 0; n < 2; ++n) _Pragma("unroll") for (int k = 0; k < 2; ++k) dst[n][k] = *(const LAS bf16x8*)(lds + PG8_SB(b, h) + boff + n * 2048 + k * 1024); } while (0)
#define PG8_MMA(ai, bj, At, Bt) do { __builtin_amdgcn_s_setprio(1); _Pragma("unroll") for (int m = 0; m < 4; ++m) _Pragma("unroll") for (int n = 0; n < 2; ++n) _Pragma("unroll") for (int k = 0; k < 2; ++k) \
        acc[ai][bj][m][n] = __builtin_amdgcn_mfma_f32_16x16x32_bf16(Bt[n][k], At[m][k], acc[ai][bj][m][n], 0, 0, 0); __builtin_amdgcn_s_setprio(0); } while (0)
#define PG8_WAIT_V(n) asm volatile("s_waitcnt vmcnt(" #n ")" ::: "memory")
#define PG8_WAIT_L(n) asm volatile("s_waitcnt lgkmcnt(" #n ")" ::: "memory")
#define PG8_BAR __builtin_amdgcn_s_barrier()
#define PG8_SCHED __builtin_amdgcn_sched_barrier(0)
    Unit cur, nxt; int ui = 0;
    if (!S.next(0, cur)) return;
    f32x4 acc[2][2][4][2];
#pragma unroll
    for (int a = 0; a < 2; ++a)
#pragma unroll
        for (int b = 0; b < 2; ++b)
#pragma unroll
            for (int m = 0; m < 4; ++m)
#pragma unroll
                for (int n = 0; n < 2; ++n) acc[a][b][m][n] = (f32x4){0.f, 0.f, 0.f, 0.f};
    bf16x8 At[4][2], B0[2][2], B1[2][2];
    float pre[8] = {0.f, 0.f, 0.f, 0.f, 0.f, 0.f, 0.f, 0.f};
    const char* cA = (const char*)g.A + (size_t)cur.pm * tstep; const char* cB = (const char*)g.Bt + (size_t)cur.pn * tstep;
    PG8_STAGE(PG8_SB(0, 0), cB, voffB); PG8_STAGE(PG8_SA(0, 0), cA, voffA); PG8_STAGE(PG8_SB(0, 1), cB + hstep, voffB); PG8_STAGE(PG8_SA(0, 1), cA + hstep, voffA);
    if (wr == 1) PG8_BAR;
    PG8_WAIT_V(4); PG8_BAR;
    PG8_STAGE(PG8_SB(1, 0), cB + kstep, voffB); PG8_STAGE(PG8_SA(1, 0), cA + kstep, voffA); PG8_STAGE(PG8_SB(1, 1), cB + hstep + kstep, voffB);
    PG8_WAIT_V(6); PG8_BAR;
    for (;;) {
        const bool has_next = S.next(ui + 1, nxt);
        const char* nA = has_next ? (const char*)g.A + (size_t)nxt.pm * tstep : cA; const char* nB = has_next ? (const char*)g.Bt + (size_t)nxt.pn * tstep : cB;
        for (int t = 0; t < nt; t += 2) {
            const bool last = (t == nt - 2);
            if (last) E.preload(pre, cur, wr, fr);
            const char* a1 = cA + (size_t)(t + 1) * kstep;
            const char* a2 = last ? nA : cA + (size_t)(t + 2) * kstep; const char* b2 = last ? nB : cB + (size_t)(t + 2) * kstep;
            const char* a3 = a2 + kstep; const char* b3 = b2 + kstep;
            PG8_LDB(B0, 0, 0); PG8_SCHED; PG8_LDA(At, 0, 0); PG8_STAGE(PG8_SA(1, 1), a1 + hstep, voffA);
            PG8_WAIT_L(8); PG8_BAR; PG8_WAIT_L(0); PG8_MMA(0, 0, At, B0); PG8_BAR; PG8_SCHED;
            PG8_LDB(B1, 0, 1); PG8_STAGE(PG8_SB(0, 0), b2, voffB);
            PG8_BAR; PG8_WAIT_L(0); PG8_MMA(0, 1, At, B1); PG8_BAR;
            PG8_LDA(At, 0, 1); PG8_STAGE(PG8_SA(0, 0), a2, voffA);
            PG8_BAR; PG8_WAIT_L(0); PG8_MMA(1, 0, At, B0); PG8_BAR; PG8_SCHED;
            PG8_STAGE(PG8_SB(0, 1), b2 + hstep, voffB);
            PG8_WAIT_V(6); PG8_BAR; PG8_MMA(1, 1, At, B1); PG8_BAR;
            PG8_LDB(B0, 1, 0); PG8_SCHED; PG8_LDA(At, 1, 0); PG8_STAGE(PG8_SA(0, 1), a2 + hstep, voffA);
            PG8_WAIT_L(8); PG8_BAR; PG8_WAIT_L(0); PG8_MMA(0, 0, At, B0); PG8_BAR; PG8_SCHED;
            PG8_LDB(B1, 1, 1); PG8_STAGE(PG8_SB(1, 0), b3, voffB);
            PG8_BAR; PG8_WAIT_L(0); PG8_MMA(0, 1, At, B1); PG8_BAR;
            PG8_LDA(At, 1, 1); PG8_STAGE(PG8_SA(1, 0), a3, voffA);
            PG8_BAR; PG8_WAIT_L(0); PG8_MMA(1, 0, At, B0); PG8_BAR; PG8_SCHED;
            PG8_STAGE(PG8_SB(1, 1), b3 + hstep, voffB);
            PG8_WAIT_V(6); PG8_BAR; PG8_MMA(1, 1, At, B1); PG8_BAR;
        }
        E(acc, cur, wr, wc, fr, fq, pre);
        if (!has_next) break;
#pragma unroll
        for (int a = 0; a < 2; ++a)
#pragma unroll
            for (int b = 0; b < 2; ++b)
#pragma unroll
                for (int m = 0; m < 4; ++m)
#pragma unroll
                    for (int n = 0; n < 2; ++n) acc[a][b][m][n] = (f32x4){0.f, 0.f, 0.f, 0.f};
        cur = nxt; cA = nA; cB = nB; ++ui;
    }
    PG8_WAIT_V(0);
    if (wr == 0) PG8_BAR;
    PG8_BAR;
#undef PG8_SA
#undef PG8_SB
#undef PG8_STAGE
#undef PG8_LDA
#undef PG8_LDB
#undef PG8_MMA
#undef PG8_WAIT_V
#undef PG8_WAIT_L
#undef PG8_BAR
#undef PG8_SCHED
}
}

__device__ __forceinline__ int cvt_seg(const float* __restrict__ src, int ldsrc, int K, const float* __restrict__ gain, bf16_t* __restrict__ dst, int src0, int dst0, int len, int base, LAS float* T, int vbid, int G) {
    const int tid = otid();
    const int ntn = (len + 255) / 256, ntk = K / 64, nt = ntn * ntk;
    const int first = ((vbid - base) % G + G) % G;
    const int kk0 = tid >> 6, n4 = (tid & 63) * 4;
    float4 vA[8], vB[8]; float gA[8], gB[8];
    const float* gp = gain ? gain : src; const float gsel = gain ? 1.f : 0.f, gone = gain ? 0.f : 1.f;
#define CVT_LOAD(v, gv, t) do { const int _tn = (t) / ntk, _tk = (t) % ntk, _n0 = _tn * 256, _k0 = _tk * 64; const int _nv = (len - _n0) < 256 ? (len - _n0) : 256; \
        const int _n4c = (n4 < _nv) ? n4 : 0;     \
        _Pragma("unroll") for (int i = 0; i < 8; ++i) { const int kk = kk0 + 8 * i; \
            v[i] = *(const float4*)(src + (size_t)(_k0 + kk) * ldsrc + src0 + _n0 + _n4c); gv[i] = fmaf(gp[_k0 + kk], gsel, gone); } } while (0)
#define CVT_TILE(v, gv, t) do { const int tn = (t) / ntk, tk = (t) % ntk, n0 = tn * 256, k0 = tk * 64; \
        const int nvalid = (len - n0) < 256 ? (len - n0) : 256; \
        if (n4 < nvalid) { _Pragma("unroll") for (int i = 0; i < 8; ++i) { LAS float* tp = T + (kk0 + 8 * i) * 257 + n4; \
            tp[0] = v[i].x * gv[i]; tp[1] = v[i].y * gv[i]; tp[2] = v[i].z * gv[i]; tp[3] = v[i].w * gv[i]; } } \
        __syncthreads(); \
        if ((t) + 2 * G < nt) CVT_LOAD(v, gv, (t) + 2 * G); \
        _Pragma("unroll") for (int r = 0; r < 4; ++r) { const int i = tid + 512 * r, n = i >> 3, kc = (i & 7) * 8; \
            if (n < nvalid) { float a[8]; _Pragma("unroll") for (int e = 0; e < 8; ++e) a[e] = T[(kc + e) * 257 + n]; \
                *(bf16x8*)(dst + (size_t)(dst0 + n0 + n) * K + k0 + kc) = pack8(a); } } \
        __syncthreads(); } while (0)
    if (first < nt) CVT_LOAD(vA, gA, first);
    if (first + G < nt) CVT_LOAD(vB, gB, first + G);
    for (int t = first; t < nt; t += 2 * G) {
        CVT_TILE(vA, gA, t);
        if (t + G < nt) CVT_TILE(vB, gB, t + G);
    }
#undef CVT_TILE
#undef CVT_LOAD
    return base + nt;
}

__device__ __forceinline__ void norm_rows(const float* __restrict__ x, bf16_t* __restrict__ h, int nrows) {
    const int tid_ = otid(), lane = tid_ & 63, gw = blockIdx.x * 8 + (tid_ >> 6), nw = gridDim.x * 8;
    for (int row = gw; row < nrows; row += nw) {
        const float4* r4 = (const float4*)(x + (size_t)row * DM);
        float4 v[8]; float ss = 0.f;
#pragma unroll
        for (int i = 0; i < 8; ++i) { v[i] = r4[lane * 2 + (i & 1) + 128 * (i >> 1)]; ss += v[i].x * v[i].x + v[i].y * v[i].y + v[i].z * v[i].z + v[i].w * v[i].w; }
#pragma unroll
        for (int o = 32; o >= 1; o >>= 1) ss += __shfl_xor(ss, o);
        const float rstd = rsqrtf(ss * (1.0f / DM) + 1e-6f);
#pragma unroll
        for (int i = 0; i < 4; ++i) { float a[8] = {v[2 * i].x * rstd, v[2 * i].y * rstd, v[2 * i].z * rstd, v[2 * i].w * rstd, v[2 * i + 1].x * rstd, v[2 * i + 1].y * rstd, v[2 * i + 1].z * rstd, v[2 * i + 1].w * rstd};
            *(bf16x8*)(h + (size_t)row * DM + (lane * 2 + 128 * i) * 4) = pack8(a); }
    }
}

__device__ __forceinline__ void final_norm(float* __restrict__ xb, const float* __restrict__ g) {
    const int tid_ = otid(), lane = tid_ & 63, gw = blockIdx.x * 8 + (tid_ >> 6), nw = gridDim.x * 8;
    for (int row = gw; row < NTOK; row += nw) {
        float4* r4 = (float4*)(xb + (size_t)row * DM);
        float4 v[8]; float ss = 0.f;
#pragma unroll
        for (int i = 0; i < 8; ++i) { v[i] = r4[lane + 64 * i]; ss += v[i].x * v[i].x + v[i].y * v[i].y + v[i].z * v[i].z + v[i].w * v[i].w; }
#pragma unroll
        for (int o = 32; o >= 1; o >>= 1) ss += __shfl_xor(ss, o);
        const float rstd = rsqrtf(ss * (1.0f / DM) + 1e-6f);
#pragma unroll
        for (int i = 0; i < 8; ++i) { const float4 gg = ((const float4*)g)[lane + 64 * i];
            float4 o4 = {v[i].x * rstd * gg.x, v[i].y * rstd * gg.y, v[i].z * rstd * gg.z, v[i].w * rstd * gg.w}; r4[lane + 64 * i] = o4; }
    }
}

__device__ __forceinline__ void rope_tables(const int* __restrict__ pos, float2* __restrict__ cs128, float2* __restrict__ cs64) {
    const int tid_ = otid(), lane = tid_ & 63, gw = blockIdx.x * 8 + (tid_ >> 6), nw = gridDim.x * 8;
    const float f128 = powf(10000.0f, -(float)(2 * lane) / 128.0f);
    const float f64 = powf(10000.0f, -(float)(2 * (lane & 31)) / 64.0f);
    for (int tok = gw; tok < NTOK; tok += nw) {
        const float p = (float)pos[tok];
        const float a = p * f128; cs128[(size_t)tok * 64 + lane] = make_float2(cosf(a), sinf(a));
        if (lane < 32) { const float b = p * f64; cs64[(size_t)tok * 32 + lane] = make_float2(cosf(b), sinf(b)); }
    }
}

__device__ __forceinline__ void fix_l1(bf16_t* Ub, const float2* cs128, const float2* cs64) {
    const int tid_ = otid(), lane = tid_ & 63, gw = blockIdx.x * 8 + (tid_ >> 6), nw = gridDim.x * 8;
    for (int t0 = gw; t0 < NTOK; t0 += 2 * nw) {
        bf16_t ka[2], kb[2], ia[2] = {0, 0}, ib[2] = {0, 0}; float2 c1[2], c2[2] = {make_float2(0.f, 0.f), make_float2(0.f, 0.f)};
#pragma unroll
        for (int j = 0; j < 2; ++j) { const int tok = t0 + j * nw; if (tok < NTOK) { bf16_t* row = Ub + (size_t)tok * 6656;
            ka[j] = row[2048 + lane]; kb[j] = row[2048 + 64 + lane]; c1[j] = cs128[(size_t)tok * 64 + lane];
            if (lane < 32) { ia[j] = row[6400 + lane]; ib[j] = row[6400 + 32 + lane]; c2[j] = cs64[(size_t)tok * 32 + lane]; } } }
#pragma unroll
        for (int j = 0; j < 2; ++j) { const int tok = t0 + j * nw; if (tok < NTOK) { bf16_t* row = Ub + (size_t)tok * 6656;
            { const float x1 = bfu2f(ka[j]), x2 = bfu2f(kb[j]); row[2048 + lane] = f2bf(x1 * c1[j].x - x2 * c1[j].y); row[2048 + 64 + lane] = f2bf(x2 * c1[j].x + x1 * c1[j].y); }
            if (lane < 32) { const float x1 = bfu2f(ia[j]), x2 = bfu2f(ib[j]); row[6400 + lane] = f2bf(x1 * c2[j].x - x2 * c2[j].y); row[6400 + 32 + lane] = f2bf(x2 * c2[j].x + x1 * c2[j].y); } } }
    }
}
__device__ __forceinline__ void fix_l2(bf16_t* Ub, const float2* cs128) {
    const int tid_ = otid(), lane = tid_ & 63, gw = blockIdx.x * 8 + (tid_ >> 6), nw = gridDim.x * 8;
    for (int t0 = gw; t0 < NTOK; t0 += 2 * nw) {
        bf16_t a[2][18], b[2][18]; float2 cs[2];
#pragma unroll
        for (int j = 0; j < 2; ++j) { const int tok = t0 + j * nw; if (tok < NTOK) { const bf16_t* row = Ub + (size_t)tok * 8704 + 2304 + lane; cs[j] = cs128[(size_t)tok * 64 + lane];
#pragma unroll
            for (int hh = 0; hh < 18; ++hh) { a[j][hh] = row[hh * 128]; b[j][hh] = row[hh * 128 + 64]; } } }
#pragma unroll
        for (int j = 0; j < 2; ++j) { const int tok = t0 + j * nw; if (tok < NTOK) { bf16_t* row = Ub + (size_t)tok * 8704 + 2304 + lane;
#pragma unroll
            for (int hh = 0; hh < 18; ++hh) { const float x1 = bfu2f(a[j][hh]), x2 = bfu2f(b[j][hh]);
                row[hh * 128] = f2bf(x1 * cs[j].x - x2 * cs[j].y); row[hh * 128 + 64] = f2bf(x2 * cs[j].x + x1 * cs[j].y); } } }
    }
}
__device__ __forceinline__ void fix_l3(bf16_t* Ub, bf16_t* CQb, bf16_t* CKVb, const float2* cs64) {
    const int tid_ = otid(), lane = tid_ & 63, gw = blockIdx.x * 8 + (tid_ >> 6), nw = gridDim.x * 8;
    for (int t0 = gw; t0 < NTOK; t0 += 2 * nw) {
        bf16x8 v[2][2]; bf16_t ra[2] = {0, 0}, rb[2] = {0, 0}; float2 c2[2] = {make_float2(0.f, 0.f), make_float2(0.f, 0.f)};
#pragma unroll
        for (int j = 0; j < 2; ++j) { const int tok = t0 + j * nw; if (tok < NTOK) { const bf16_t* row = Ub + (size_t)tok * 4352;
            v[j][0] = *(const bf16x8*)(row + lane * 8); v[j][1] = *(const bf16x8*)(row + 512 + lane * 8);
            if (lane < 32) { ra[j] = row[4096 + lane]; rb[j] = row[4096 + 32 + lane]; c2[j] = cs64[(size_t)tok * 32 + lane]; } } }
#pragma unroll
        for (int j = 0; j < 2; ++j) { const int tok = t0 + j * nw; if (tok < NTOK) { bf16_t* row = Ub + (size_t)tok * 4352;
#pragma unroll
            for (int w = 0; w < 2; ++w) { float a[8]; float ss = 0.f;
#pragma unroll
                for (int e = 0; e < 8; ++e) { a[e] = bf2f(v[j][w][e]); ss += a[e] * a[e]; }
#pragma unroll
                for (int o = 32; o >= 1; o >>= 1) ss += __shfl_xor(ss, o);
                const float rstd = rsqrtf(ss * (1.0f / 512.0f) + 1e-6f);
#pragma unroll
                for (int e = 0; e < 8; ++e) a[e] *= rstd;
                *(bf16x8*)((w ? CKVb : CQb) + (size_t)tok * 512 + lane * 8) = pack8(a); }
            if (lane < 32) { const float x1 = bfu2f(ra[j]), x2 = bfu2f(rb[j]); row[4096 + lane] = f2bf(x1 * c2[j].x - x2 * c2[j].y); row[4096 + 32 + lane] = f2bf(x2 * c2[j].x + x1 * c2[j].y); } } }
    }
}


__device__ __forceinline__ void krope_gemm(LAS unsigned char* L, const bf16_t* __restrict__ Hb, const bf16_t* __restrict__ Wt, const float* __restrict__ ssq, bf16_t* __restrict__ Ub) {
    const int tid = otid(), wid = tid >> 6, lane = tid & 63, r32 = lane & 31, hi = lane >> 5;
    LAS float* red = (LAS float*)L;
    for (int rt = blockIdx.x; rt < NTOK / 32; rt += gridDim.x) {
        const int row0 = rt * 32, k0 = wid * 256;
        const bf16_t* ap = Hb + (size_t)(row0 + r32) * DM + k0 + 8 * hi;
        const bf16_t* bp0 = Wt + (size_t)r32 * DM + k0 + 8 * hi; const bf16_t* bp1 = bp0 + (size_t)32 * DM;
        f32x16 c0 = {}, c1 = {};
#pragma unroll
        for (int ks = 0; ks < 16; ++ks) { const bf16x8 a = *(const bf16x8*)(ap + 16 * ks), b0 = *(const bf16x8*)(bp0 + 16 * ks), b1 = *(const bf16x8*)(bp1 + 16 * ks);
            c0 = __builtin_amdgcn_mfma_f32_32x32x16_bf16(a, b0, c0, 0, 0, 0); c1 = __builtin_amdgcn_mfma_f32_32x32x16_bf16(a, b1, c1, 0, 0, 0); }
#pragma unroll
        for (int i = 0; i < 16; ++i) { red[((wid * 2 + 0) * 16 + i) * 64 + lane] = c0[i]; red[((wid * 2 + 1) * 16 + i) * 64 + lane] = c1[i]; }
        __syncthreads();
#pragma unroll
        for (int q = 0; q < 4; ++q) { const int idx = tid + 512 * q, blk = idx >> 10, i = (idx >> 6) & 15, ln = idx & 63;
            float sum = 0.f;
#pragma unroll
            for (int w = 0; w < 8; ++w) sum += red[((w * 2 + blk) * 16 + i) * 64 + ln];
            const int row = row0 + (i & 3) + 8 * (i >> 2) + 4 * (ln >> 5), col = 32 * blk + (ln & 31);
            const float rs = rsqrtf(ssq[row] * (1.0f / DM) + 1e-6f);
            Ub[(size_t)row * 4352 + 4096 + col] = f2bf(sum * rs); }
        __syncthreads();
    }
}

__device__ __forceinline__ unsigned f2ord(float f) { const unsigned b = __float_as_uint(f); return (b & 0x80000000u) ? ~b : (b | 0x80000000u); }
__device__ __forceinline__ void phase_indexer(const bf16_t* __restrict__ U, const float2* __restrict__ cs64, unsigned* __restrict__ MASK) {
    constexpr int LDU = 6656;
    const int tid_ = otid(), lane = tid_ & 63, gw = blockIdx.x * 8 + (tid_ >> 6), nw = gridDim.x * 8;
    const int m = lane & 31, kh = lane >> 5, aq = (m >> 2) & 1, ah = ((m >> 3) << 2) | (m & 3);
    for (int task0 = gw; task0 < 2048; task0 += nw)
        for (int half = 0; half < 2; ++half) {
            const int task = half ? 4095 - task0 : task0;
            const int b = task >> 10, p = task & 1023, tokA = b * SEQ + 2 * p;
            bf16x8 a[4];
            { const bf16_t* src = U + (size_t)(tokA + aq) * LDU + 2304 + ah * 64 + kh * 8;
#pragma unroll
              for (int kk = 0; kk < 4; ++kk) a[kk] = *(const bf16x8*)(src + 16 * kk);
              const float2* cs = cs64 + (size_t)(tokA + aq) * 32 + kh * 8;
#pragma unroll
              for (int kk = 0; kk < 2; ++kk) { float y1[8], y2[8];
#pragma unroll
                  for (int e = 0; e < 8; ++e) { const float2 c = cs[16 * kk + e]; const float x1 = bf2f(a[kk][e]), x2 = bf2f(a[kk + 2][e]); y1[e] = x1 * c.x - x2 * c.y; y2[e] = x2 * c.x + x1 * c.y; }
                  a[kk] = pack8(y1); a[kk + 2] = pack8(y2); } }
            float wl[16];
            { const bf16_t* wp = U + (size_t)(tokA + kh) * LDU + 6528; const bf16x8 w0 = *(const bf16x8*)wp, w1 = *(const bf16x8*)(wp + 8);
#pragma unroll
              for (int e = 0; e < 8; ++e) { wl[e] = bf2f(w0[e]); wl[8 + e] = bf2f(w1[e]); } }
            const int qpos = 2 * p + kh, tmax = (2 * p + 1) >> 5;
            const bf16_t* kb = U + (size_t)(b * SEQ + m) * LDU + 6400 + kh * 8;
            unsigned sc[64];
            bf16x8 bn[4];
#pragma unroll
            for (int kk = 0; kk < 4; ++kk) bn[kk] = *(const bf16x8*)(kb + 16 * kk);
#pragma unroll
            for (int t = 0; t < 64; ++t) {
                if (t <= tmax) {
                    bf16x8 bc[4];
#pragma unroll
                    for (int kk = 0; kk < 4; ++kk) bc[kk] = bn[kk];
                    if (t + 1 <= tmax) {
#pragma unroll
                        for (int kk = 0; kk < 4; ++kk) bn[kk] = *(const bf16x8*)(kb + (size_t)(32 * (t + 1)) * LDU + 16 * kk); }
                    f32x16 acc = {};
#pragma unroll
                    for (int kk = 0; kk < 4; ++kk) acc = __builtin_amdgcn_mfma_f32_32x32x16_bf16(a[kk], bc[kk], acc, 0, 0, 0);
                    float s = 0.f;
#pragma unroll
                    for (int i = 0; i < 16; ++i) s = fmaf(wl[i], fmaxf(acc[i], 0.f), s);
                    sc[t] = (32 * t + m <= qpos) ? f2ord(s) : 0u;
                } else sc[t] = 0u;
            }
            unsigned T = 0u;
            bool done = (qpos < 256);
            for (int bit = 31; bit >= 0; --bit) {
                if (__all(done)) break;
                const unsigned cand = T | (1u << bit);
                int cnt = 0;
#pragma unroll
                for (int t = 0; t < 64; ++t) cnt += (sc[t] >= cand) ? 1 : 0;
                cnt += __shfl_xor(cnt, 16); cnt += __shfl_xor(cnt, 8); cnt += __shfl_xor(cnt, 4); cnt += __shfl_xor(cnt, 2); cnt += __shfl_xor(cnt, 1);
                if (!done && cnt >= 256) { T = cand; done = (cnt == 256); }
            }
            const unsigned thr = T < 1u ? 1u : T;
            unsigned mwA = 0u, mwB = 0u;
#pragma unroll
            for (int t = 0; t < 64; ++t) { const unsigned long long bal = __ballot(sc[t] >= thr);
                if (lane == t) { mwA = (unsigned)bal; mwB = (unsigned)(bal >> 32); } }
            MASK[(size_t)tokA * 64 + lane] = mwA; MASK[(size_t)(tokA + 1) * 64 + lane] = mwB;
        }
}

#define KSWZ(row, colB) ((row) * 256 + ((colB) ^ (((row) & 7) << 4)))
#define KRSWZ(row, colB) ((row) * 128 + ((colB) ^ ((((row) >> 1) & 7) << 4)))
constexpr int A_V = 0, A_K = 65536, A_KR = 114688, A_WS = 139264, A_CB = 141312, A_SC = 149504;
__device__ __forceinline__ int crow(int r, int hi) { return (r & 3) + 8 * (r >> 2) + 4 * hi; }
__device__ __forceinline__ int v_st(int k, int c) { const int kk = (k & ~0xC) | ((k & 4) << 1) | ((k & 8) >> 1); return ((kk >> 3) * 4 + (c >> 5)) * 512 + ((kk & 7) * 32 + (c & 31)) * 2; }
__device__ __forceinline__ int v_rd_base(int lane) { return ((lane & 3) << 3) | (((lane >> 2) & 3) << 6) | (((lane >> 4) & 1) << 5) | (((lane >> 5) & 1) << 8); }
constexpr int v_rd_off(int d0, int ks, int half) { return d0 * 512 + ks * 4096 + half * 2048; }
template <int OFF> __device__ __forceinline__ s16x4 tr_read(int vb) {
    s16x4 r; asm volatile("ds_read_b64_tr_b16 %0, %1 offset:%2" : "=&v"(r) : "v"(vb), "i"(OFF) : "memory"); return r;
}
template <int D0> __device__ __forceinline__ void pv_two(f32x16& oa, f32x16& ob, int vb, bf16x8 pa0, bf16x8 pa1, bf16x8 pa2, bf16x8 pa3) {
    const s16x4 l0 = tr_read<v_rd_off(D0, 0, 0)>(vb), h0 = tr_read<v_rd_off(D0, 0, 1)>(vb), l1 = tr_read<v_rd_off(D0, 1, 0)>(vb), h1 = tr_read<v_rd_off(D0, 1, 1)>(vb);
    const s16x4 l2 = tr_read<v_rd_off(D0, 2, 0)>(vb), h2 = tr_read<v_rd_off(D0, 2, 1)>(vb), l3 = tr_read<v_rd_off(D0, 3, 0)>(vb), h3 = tr_read<v_rd_off(D0, 3, 1)>(vb);
    const s16x4 m0 = tr_read<v_rd_off(D0 + 1, 0, 0)>(vb), n0 = tr_read<v_rd_off(D0 + 1, 0, 1)>(vb), m1 = tr_read<v_rd_off(D0 + 1, 1, 0)>(vb), n1 = tr_read<v_rd_off(D0 + 1, 1, 1)>(vb);
    const s16x4 m2 = tr_read<v_rd_off(D0 + 1, 2, 0)>(vb), n2 = tr_read<v_rd_off(D0 + 1, 2, 1)>(vb), m3 = tr_read<v_rd_off(D0 + 1, 3, 0)>(vb), n3 = tr_read<v_rd_off(D0 + 1, 3, 1)>(vb);
    asm volatile("s_waitcnt lgkmcnt(0)" ::: "memory"); __builtin_amdgcn_sched_barrier(0);
#define PK(L, H) (bf16x8){L[0], L[1], L[2], L[3], H[0], H[1], H[2], H[3]}
    oa = __builtin_amdgcn_mfma_f32_32x32x16_bf16(pa0, PK(l0, h0), oa, 0, 0, 0);
    ob = __builtin_amdgcn_mfma_f32_32x32x16_bf16(pa0, PK(m0, n0), ob, 0, 0, 0);
    oa = __builtin_amdgcn_mfma_f32_32x32x16_bf16(pa1, PK(l1, h1), oa, 0, 0, 0);
    ob = __builtin_amdgcn_mfma_f32_32x32x16_bf16(pa1, PK(m1, n1), ob, 0, 0, 0);
    oa = __builtin_amdgcn_mfma_f32_32x32x16_bf16(pa2, PK(l2, h2), oa, 0, 0, 0);
    ob = __builtin_amdgcn_mfma_f32_32x32x16_bf16(pa2, PK(m2, n2), ob, 0, 0, 0);
    oa = __builtin_amdgcn_mfma_f32_32x32x16_bf16(pa3, PK(l3, h3), oa, 0, 0, 0);
    ob = __builtin_amdgcn_mfma_f32_32x32x16_bf16(pa3, PK(m3, n3), ob, 0, 0, 0);
#undef PK
}

enum { K_FOX = 0, K_DSA = 1, K_DIL = 2, K_MLA = 3, K_MEM = 4 };

template <int KIND>
__device__ __forceinline__ void load_q(bf16x8 (&qr)[12], const bf16_t* __restrict__ qp, const float2* __restrict__ c128, const float2* __restrict__ c64, int hi, float C) {
#pragma unroll
    for (int d0 = 0; d0 < 8; ++d0) qr[d0] = *(const bf16x8*)(qp + hi * 8 + d0 * 16);
#pragma unroll
    for (int d0 = 0; d0 < 4; ++d0) qr[8 + d0] = (KIND == K_MLA) ? *(const bf16x8*)(qp + 128 + hi * 8 + d0 * 16) : (bf16x8){0, 0, 0, 0, 0, 0, 0, 0};
    if (KIND == K_DSA || KIND == K_DIL) {
#pragma unroll
        for (int d0 = 0; d0 < 4; ++d0) { const float2* cs = c128 + 16 * d0 + 8 * hi; float y1[8], y2[8];
#pragma unroll
            for (int e = 0; e < 8; ++e) { const float2 c = cs[e]; const float x1 = bf2f(qr[d0][e]), x2 = bf2f(qr[d0 + 4][e]); y1[e] = (x1 * c.x - x2 * c.y) * C; y2[e] = (x2 * c.x + x1 * c.y) * C; }
            qr[d0] = pack8(y1); qr[d0 + 4] = pack8(y2); }
    } else {
#pragma unroll
        for (int d0 = 0; d0 < 8; ++d0) { float y[8];
#pragma unroll
            for (int e = 0; e < 8; ++e) y[e] = bf2f(qr[d0][e]) * C;
            qr[d0] = pack8(y); }
    }
    if (KIND == K_MLA) {
#pragma unroll
        for (int d0 = 0; d0 < 2; ++d0) { const float2* cs = c64 + 16 * d0 + 8 * hi; float y1[8], y2[8];
#pragma unroll
            for (int e = 0; e < 8; ++e) { const float2 c = cs[e]; const float x1 = bf2f(qr[8 + d0][e]), x2 = bf2f(qr[10 + d0][e]); y1[e] = (x1 * c.x - x2 * c.y) * C; y2[e] = (x2 * c.x + x1 * c.y) * C; }
            qr[8 + d0] = pack8(y1); qr[10 + d0] = pack8(y2); }
    }
}

__device__ __forceinline__ void attn_finish(f32x16 (&o)[4], float& m_reg, float& l_reg, f32x16& p0, f32x16& p1, int vb, LAS float* al_l, int r32, int hi) {
            float pmax = p0[0];
#pragma unroll
            for (int r = 1; r < 16; ++r) pmax = fmaxf(pmax, p0[r]);
#pragma unroll
            for (int r = 0; r < 16; ++r) pmax = fmaxf(pmax, p1[r]);
            { auto rr = __builtin_amdgcn_permlane32_swap(__float_as_uint(pmax), __float_as_uint(pmax), false, false);
              pmax = fmaxf(__uint_as_float(rr[0]), __uint_as_float(rr[1])); }
            float mn = m_reg, alpha = 1.f;
            const bool resc = !__all(pmax - m_reg <= 10.0f);
            if (resc) { mn = fmaxf(m_reg, pmax); alpha = __builtin_amdgcn_exp2f(m_reg - mn); m_reg = mn; }
            float ps = 0.f;
#pragma unroll
            for (int r = 0; r < 16; ++r) { p0[r] = __builtin_amdgcn_exp2f(p0[r] - mn); p1[r] = __builtin_amdgcn_exp2f(p1[r] - mn); }
#pragma unroll
            for (int r = 0; r < 16; ++r) ps += p0[r] + p1[r];
            { auto rr = __builtin_amdgcn_permlane32_swap(__float_as_uint(ps), __float_as_uint(ps), false, false);
              ps = __uint_as_float(rr[0]) + __uint_as_float(rr[1]); }
            l_reg = l_reg * alpha + ps;
            bf16x8 pa0, pa1, pa2, pa3;
#define PK4(P, BASE, OUT) do { unsigned a0 = cvtpk(P[BASE + 0], P[BASE + 1]), a1 = cvtpk(P[BASE + 2], P[BASE + 3]);   \
    unsigned b0 = cvtpk(P[BASE + 4], P[BASE + 5]), b1 = cvtpk(P[BASE + 6], P[BASE + 7]);                              \
    auto r0 = __builtin_amdgcn_permlane32_swap(a0, b0, false, false); auto r1 = __builtin_amdgcn_permlane32_swap(a1, b1, false, false); \
    u32x4 w = {r0[0], r1[0], r0[1], r1[1]}; OUT = __builtin_bit_cast(bf16x8, w); } while (0)
            PK4(p0, 0, pa0); PK4(p0, 8, pa1); PK4(p1, 0, pa2); PK4(p1, 8, pa3);
#undef PK4
            if (resc) { if (hi == 0) al_l[r32] = alpha; asm volatile("s_waitcnt lgkmcnt(0)" ::: "memory");
#pragma unroll
                for (int r = 0; r < 16; ++r) { const float al = al_l[crow(r, hi)];
#pragma unroll
                    for (int d = 0; d < 4; ++d) o[d][r] *= al; } }
            pv_two<0>(o[0], o[1], vb, pa0, pa1, pa2, pa3); pv_two<2>(o[2], o[3], vb, pa0, pa1, pa2, pa3);
}

template <int KIND>
__device__ __forceinline__ void attn_segment(LAS unsigned char* L, f32x16 (&o)[4], float& m_reg, float& l_reg, const bf16x8 (&qr)[12],
        const bf16_t* __restrict__ Kp, const bf16_t* __restrict__ Vp, int ldk, int ldv, const bf16_t* __restrict__ KRp, int ldkr,
        int kt0, int kts, int j0, int j1, int tq, int tq_lo, int tq_hi, int wtok, int dmask, float C, const unsigned* __restrict__ maskrow) {
    const int tid = otid(), wid = tid >> 6, lane = tid & 63, r32 = lane & 31, hi = lane >> 5;
    LAS float* al_l = (LAS float*)(L + A_WS) + wid * 64 + 32;
    const int vbase = (int)(unsigned)(uintptr_t)(L + A_V) + v_rd_base(lane);
    int kx[4], krx[4];
#pragma unroll
    for (int q = 0; q < 4; ++q) { kx[q] = KSWZ(r32, (q * 16 + hi * 8) * 2); krx[q] = KRSWZ(r32, (q * 16 + hi * 8) * 2); }
    const int wu = __builtin_amdgcn_readfirstlane(wid);
    unsigned ksrc[2], vsrc[2], krsrc = 0u;
#pragma unroll
    for (int q = 0; q < 2; ++q) {
        const int krow = 4 * (2 * wu + q) + (lane >> 4), kcol = 8 * ((lane & 15) ^ (krow & 7));
        ksrc[q] = (unsigned)(kt0 + krow * kts) * (unsigned)ldk + (unsigned)kcol;
        const int kk = 8 * wu + ((lane & 31) >> 2), vk = (kk & ~0xC) | ((kk & 4) << 1) | ((kk & 8) >> 1), vc = 32 * ((2 * q + (lane >> 5)) & 3) + 8 * (lane & 3);
        vsrc[q] = (unsigned)(kt0 + vk * kts) * (unsigned)ldv + (unsigned)vc;
    }
    if (KIND == K_MLA) { const int rrow = 8 * wu + (lane >> 3), rcol = 8 * ((lane & 7) ^ ((rrow >> 1) & 7)); krsrc = (unsigned)(kt0 + rrow * kts) * (unsigned)ldkr + (unsigned)rcol; }
    const unsigned kstep = 64u * (unsigned)kts * (unsigned)ldk, vstep = 64u * (unsigned)kts * (unsigned)ldv, krstep = 64u * (unsigned)kts * (unsigned)ldkr;
    uint2 mw = make_uint2(0u, 0u), mwn = make_uint2(0u, 0u);
#define DMA16(gp, lp) __builtin_amdgcn_global_load_lds((const unsigned*)(gp), (LAS unsigned*)(lp), 16, 0, 0)
#define STAGE(j, kslot, vslot) do { _Pragma("unroll") for (int _q = 0; _q < 2; ++_q) { \
            DMA16(Kp + (ksrc[_q] + (unsigned)(j) * kstep), L + A_K + (kslot) * 16384 + (2 * wu + _q) * 1024); \
            DMA16(Vp + (vsrc[_q] + (unsigned)(j) * vstep), L + A_V + (vslot) * 16384 + (2 * wu + _q) * 1024); } \
        if (KIND == K_MLA) DMA16(KRp + (krsrc + (unsigned)(j) * krstep), L + A_KR + (kslot) * 8192 + wu * 1024); } while (0)
#define WAIT_TILE() do { if (KIND == K_MLA) asm volatile("s_waitcnt vmcnt(5)" ::: "memory"); else asm volatile("s_waitcnt vmcnt(4)" ::: "memory"); } while (0)
    const bool grpB = (wu >= 4);
    int kc = 0, vc = 0;
    if (KIND == K_DSA) mw = *(const uint2*)(maskrow + 2 * j0);
    STAGE(j0, 0, 0);
    if (j0 + 1 < j1) { if (KIND == K_DSA) mwn = *(const uint2*)(maskrow + 2 * (j0 + 1)); STAGE(j0 + 1, 1, 1); WAIT_TILE(); }
    else asm volatile("s_waitcnt vmcnt(0)" ::: "memory");
    __syncthreads();
    f32x16 p0 = {}, p1 = {};
    bool pvalid = false;
    for (int j = j0; j <= j1; ++j) {
        const bool st2 = (j + 2 < j1);
        uint2 mwnn = make_uint2(0u, 0u);
        if (st2) { if (KIND == K_DSA) mwnn = *(const uint2*)(maskrow + 2 * (j + 2)); STAGE(j + 2, (kc + 2) % 3, (vc + 2) & 3); }
        if (grpB && pvalid) attn_finish(o, m_reg, l_reg, p0, p1, vbase + ((vc + 3) & 3) * 16384, al_l, r32, hi);
        pvalid = false;
        if (j < j1) {
            const int tkmin = kt0 + 64 * j * kts, tkmax = tkmin + 63 * kts;
            const bool need = (KIND == K_MEM) || (tkmin <= tq_hi && tkmax >= tq_lo - wtok);
            if (need) {
                pvalid = true;
                if (KIND == K_FOX) {
#pragma unroll
                    for (int g = 0; g < 4; ++g) { const f32x4 c0 = *(const LAS f32x4*)(L + A_CB + (64 * j + 4 * hi + 8 * g) * 4), c1 = *(const LAS f32x4*)(L + A_CB + (64 * j + 32 + 4 * hi + 8 * g) * 4);
#pragma unroll
                        for (int e = 0; e < 4; ++e) { p0[4 * g + e] = c0[e]; p1[4 * g + e] = c1[e]; } }
                } else {
#pragma unroll
                    for (int r = 0; r < 16; ++r) { p0[r] = 0.f; p1[r] = 0.f; }
                }
            { LAS unsigned char* Kb = L + A_K + kc * 16384;
#pragma unroll
              for (int d0 = 0; d0 < 8; ++d0) { LAS unsigned char* ka = Kb + kx[d0 & 3] + (d0 >> 2) * 128;
                  const bf16x8 b0 = *(const LAS bf16x8*)(ka), b1 = *(const LAS bf16x8*)(ka + 8192);
                  p0 = __builtin_amdgcn_mfma_f32_32x32x16_bf16(b0, qr[d0], p0, 0, 0, 0);
                  p1 = __builtin_amdgcn_mfma_f32_32x32x16_bf16(b1, qr[d0], p1, 0, 0, 0);
                  if (KIND == K_MLA && (d0 & 3) == 3) __builtin_amdgcn_sched_barrier(0); } }
            if (KIND == K_MLA) { LAS unsigned char* Kr = L + A_KR + kc * 8192;
#pragma unroll
              for (int d0 = 0; d0 < 4; ++d0) { LAS unsigned char* ka = Kr + krx[d0];
                  const bf16x8 b0 = *(const LAS bf16x8*)(ka), b1 = *(const LAS bf16x8*)(ka + 4096);
                  p0 = __builtin_amdgcn_mfma_f32_32x32x16_bf16(b0, qr[8 + d0], p0, 0, 0, 0);
                  p1 = __builtin_amdgcn_mfma_f32_32x32x16_bf16(b1, qr[8 + d0], p1, 0, 0, 0);
                  __builtin_amdgcn_sched_barrier(0); } }
            if (KIND == K_DSA) { const int sh0 = (int)(mw.x >> (4 * hi)), sh1 = (int)(mw.y >> (4 * hi));
#pragma unroll
                for (int r = 0; r < 16; ++r) { const int cr = (r & 3) + 8 * (r >> 2);
                    const unsigned t0 = (unsigned)__builtin_amdgcn_sbfe(sh0, cr, 1), t1 = (unsigned)__builtin_amdgcn_sbfe(sh1, cr, 1);
                    p0[r] = __uint_as_float((__float_as_uint(p0[r]) & t0) | (0xFF800000u & ~t0)); p1[r] = __uint_as_float((__float_as_uint(p1[r]) & t1) | (0xFF800000u & ~t1)); }
            } else if (KIND != K_MEM) {
                const bool allvalid = (dmask == 0) && (tkmax <= tq_lo) && (tkmin >= tq_hi - wtok);
                if (!allvalid) { const int dbase = tq - kt0 - kts * (64 * j + 4 * hi);
#pragma unroll
                    for (int r = 0; r < 16; ++r) { const int cr = (r & 3) + 8 * (r >> 2); const int d = dbase - kts * cr, d1 = d - 32 * kts;
                        const bool v0 = ((unsigned)d <= (unsigned)wtok) && ((d & dmask) == 0), v1 = ((unsigned)d1 <= (unsigned)wtok) && ((d1 & dmask) == 0);
                        p0[r] = v0 ? p0[r] : -INFINITY; p1[r] = v1 ? p1[r] : -INFINITY; } }
            }
            }
        }
        if (!grpB && pvalid) { attn_finish(o, m_reg, l_reg, p0, p1, vbase + vc * 16384, al_l, r32, hi); pvalid = false; }
        if (KIND == K_DSA) { mw = mwn; mwn = mwnn; }
        if (st2) WAIT_TILE(); else asm volatile("s_waitcnt vmcnt(0)" ::: "memory");
        __syncthreads();
        kc = (kc == 2) ? 0 : kc + 1; vc = (vc + 1) & 3;
    }
#undef STAGE
#undef WAIT_TILE
#undef DMA16
}

__device__ __forceinline__ void attn_epilogue(LAS unsigned char* L, const f32x16 (&o)[4], float l_reg, int tok0, int tstride,
        const bf16_t* __restrict__ Z, int ldz, bf16_t* __restrict__ Gd, int ldg) {
    const int tid = otid(), wid = tid >> 6, lane = tid & 63, r32 = lane & 31, hi = lane >> 5;
    LAS float* li_l = (LAS float*)(L + A_WS) + wid * 64;
    if (hi == 0) li_l[r32] = l_reg;
    asm volatile("s_waitcnt lgkmcnt(0)" ::: "memory");
#pragma unroll
    for (int rb = 0; rb < 2; ++rb) {
        bf16_t zv[8][4]; float rl[8]; unsigned toff[8];
#pragma unroll
        for (int rr = 0; rr < 8; ++rr) { const int r = 8 * rb + rr, row = crow(r, hi);
            const unsigned tok = (unsigned)(tok0 + (32 * wid + row) * tstride); toff[rr] = tok;
            const bf16_t* zp = Z + tok * (unsigned)ldz + r32;
#pragma unroll
            for (int d0 = 0; d0 < 4; ++d0) zv[rr][d0] = zp[32 * d0];
            rl[rr] = __builtin_amdgcn_rcpf(li_l[row]); }
#pragma unroll
        for (int rr = 0; rr < 8; ++rr) { const int r = 8 * rb + rr;
            bf16_t* gp = Gd + toff[rr] * (unsigned)ldg + r32;
#pragma unroll
            for (int d0 = 0; d0 < 4; ++d0) { const float y = o[d0][r] * rl[rr]; const float z = bfu2f(zv[rr][d0]);
                gp[32 * d0] = f2bf(y * z * __builtin_amdgcn_rcpf(1.0f + __expf(-z))); } }
    }
}

__device__ __forceinline__ void mem_items(LAS unsigned char* L, int it0, int itstep, const bf16_t* __restrict__ U, int ldu, int qcol, int zcol, const bf16_t* __restrict__ MKV, int layer, bf16_t* __restrict__ Gd, int ldg, int gcol) {
    const int tid = otid(), wid = tid >> 6, lane = tid & 63, r32 = lane & 31, hi = lane >> 5;
    for (int it = it0; it < 128; it += itstep) {
        const int qb = it & 7, mh = (it >> 3) & 3, b = it >> 5;
        const int tok0 = b * SEQ + qb * 256, tq = qb * 256 + 32 * wid + r32;
        bf16x8 qr[12];
        load_q<K_MEM>(qr, U + (size_t)(tok0 + 32 * wid + r32) * ldu + qcol + mh * 128, nullptr, nullptr, hi, 0.088388347648318440f * LOG2E);
        f32x16 o[4] = {}; float m_reg = -1e30f, l_reg = 0.f;
        const bf16_t* Kp = MKV + (size_t)(b * 256) * 4096 + layer * 1024 + mh * 128;
        attn_segment<K_MEM>(L, o, m_reg, l_reg, qr, Kp, Kp + 512, 4096, 4096, nullptr, 0, 0, 1, 0, 4, tq, 0, 0, 0, 0, 0.088388347648318440f * LOG2E, nullptr);
        attn_epilogue(L, o, l_reg, tok0, 1, U + zcol + mh * 128, ldu, Gd + gcol + mh * 128, ldg);
    }
}

template <int KIND>
__device__ __forceinline__ void causal_items(LAS unsigned char* L, int it0, const Params& p, const bf16_t* __restrict__ U, int ldu, bf16_t* __restrict__ Gd) {
    const int tid = otid(), wid = tid >> 6, lane = tid & 63, r32 = lane & 31, hi = lane >> 5;
    const float2* cs128 = (const float2*)(p.ws + WS_CS128); const float2* cs64 = (const float2*)(p.ws + WS_CS64);
    for (int it = it0; it < 256; it += gridDim.x) {
        const int x = it & 3, h = (it >> 2) & 15, b = it >> 6;
        if (KIND == K_FOX) {
            float lf[4]; const float fb = p.in[5][h];
#pragma unroll
            for (int e = 0; e < 4; ++e) { const float xx = bfu2f(U[(size_t)(b * SEQ + 4 * tid + e) * ldu + 9216 + h]) + fb;
                lf[e] = (xx >= 0.f) ? -log1pf(expf(-xx)) : xx - log1pf(expf(xx)); }
            const float s1 = lf[0], s2 = s1 + lf[1], s3 = s2 + lf[2], s4 = s3 + lf[3];
            float inc = s4;
#pragma unroll
            for (int d = 1; d < 64; d <<= 1) { const float t = __shfl_up(inc, d); if (lane >= d) inc += t; }
            LAS float* wsum = (LAS float*)(L + A_SC);
            if (lane == 63) wsum[wid] = inc;
            __syncthreads();
            float off = 0.f;
            for (int w = 0; w < wid; ++w) off += wsum[w];
            const float ex = off + inc - s4;
            f32x4 cb = {-(ex + s1) * LOG2E, -(ex + s2) * LOG2E, -(ex + s3) * LOG2E, -(ex + s4) * LOG2E};
            *(LAS f32x4*)(L + A_CB + tid * 16) = cb;
            __syncthreads();
        }
        for (int sub = 0; sub < 2; ++sub) {
            const int qb = sub ? x : 7 - x;
            const int tok0 = b * SEQ + qb * 256, tql = qb * 256 + 32 * wid, tq = tql + r32, mytok = tok0 + 32 * wid + r32;
            bf16x8 qr[12];
            f32x16 o[4] = {}; float m_reg = -1e30f, l_reg = 0.f;
            if (KIND == K_FOX) {
                load_q<K_FOX>(qr, U + (size_t)mytok * ldu + h * 128, nullptr, nullptr, hi, 0.088388347648318440f * LOG2E);
                const bf16_t* Kp = U + (size_t)(b * SEQ) * ldu + 2048 + h * 128;
                attn_segment<K_FOX>(L, o, m_reg, l_reg, qr, Kp, Kp + 2048, ldu, ldu, nullptr, 0, 0, 1, 0, 4 * (qb + 1), tq, tql, tql + 31, 0x7fffffff, 0, 0.088388347648318440f * LOG2E, nullptr);
                attn_epilogue(L, o, l_reg, tok0, 1, U + 6656 + h * 128, ldu, Gd + h * 128, 2560);
            } else if (KIND == K_DSA) {
                load_q<K_DSA>(qr, U + (size_t)mytok * ldu + h * 128, cs128 + (size_t)mytok * 64, nullptr, hi, 0.088388347648318440f * LOG2E);
                const bf16_t* Kp = U + (size_t)(b * SEQ) * ldu + 2048;
                attn_segment<K_DSA>(L, o, m_reg, l_reg, qr, Kp, Kp + 128, ldu, ldu, nullptr, 0, 0, 1, 0, 4 * (qb + 1), tq, tql, tql + 31, 0x7fffffff, 0, 0.088388347648318440f * LOG2E,
                                    (const unsigned*)(p.ws + WS_MASK) + (size_t)mytok * 64);
                attn_epilogue(L, o, l_reg, tok0, 1, U + 3840 + h * 128, ldu, Gd + h * 128, 2560);
            } else {
                const bf16_t* Q3 = (const bf16_t*)(p.ws + WS_Q3); const bf16_t* KV3 = (const bf16_t*)(p.ws + WS_KV3);
                load_q<K_MLA>(qr, Q3 + (size_t)mytok * 3072 + h * 192, nullptr, cs64 + (size_t)mytok * 32, hi, 0.072168783648703220f * LOG2E);
                const bf16_t* Kp = KV3 + (size_t)(b * SEQ) * 4096 + h * 256;
                attn_segment<K_MLA>(L, o, m_reg, l_reg, qr, Kp, Kp + 128, 4096, 4096, U + (size_t)(b * SEQ) * ldu + 4096, ldu, 0, 1, 0, 4 * (qb + 1), tq, tql, tql + 31, 0x7fffffff, 0,
                                    0.072168783648703220f * LOG2E, nullptr);
                attn_epilogue(L, o, l_reg, tok0, 1, U + 1536 + h * 128, ldu, Gd + h * 128, 2560);
            }
        }
    }
}

__device__ __forceinline__ void dilA_items(LAS unsigned char* L, int it0, const Params& p, const bf16_t* __restrict__ U, float* __restrict__ SO, float* __restrict__ SML) {
    constexpr int ldu = 8704;
    const int tid = otid(), wid = tid >> 6, lane = tid & 63, r32 = lane & 31, hi = lane >> 5;
    const float2* cs128 = (const float2*)(p.ws + WS_CS128);
    for (int it = it0; it < 192; it += gridDim.x) {
        const int qb = it & 7, gq = it >> 3, hg = gq % 6, b = gq / 6;
        const int tok0 = b * SEQ + qb * 256, tql = qb * 256 + 32 * wid, tq = tql + r32, mytok = tok0 + 32 * wid + r32;
        f32x16 o[4] = {}; float m_reg = -1e30f, l_reg = 0.f;
        bf16x8 qr[12];
        load_q<K_DIL>(qr, U + (size_t)mytok * ldu + hg * 128, cs128 + (size_t)mytok * 64, nullptr, hi, 0.088388347648318440f * LOG2E);
        const bf16_t* Kp = U + (size_t)(b * SEQ) * ldu + 2304 + hg * 128;
        attn_segment<K_DIL>(L, o, m_reg, l_reg, qr, Kp, Kp + 2304, ldu, ldu, nullptr, 0, 0, 1, qb ? 4 * qb - 2 : 0, 4 * (qb + 1), tq, tql, tql + 31, 128, 0, 0.088388347648318440f * LOG2E, nullptr);
        float* so = SO + ((size_t)tok0 * 6 + hg) * 128;
#pragma unroll
        for (int r = 0; r < 16; ++r) { const unsigned off = (unsigned)((32 * wid + crow(r, hi)) * 768 + r32);
#pragma unroll
            for (int d0 = 0; d0 < 4; ++d0) so[off + 32u * d0] = o[d0][r]; }
        if (hi == 0) { float* ml = SML + ((size_t)mytok * 6 + hg) * 2; ml[0] = m_reg; ml[1] = l_reg; }
    }
}
__device__ __forceinline__ void dil_items(LAS unsigned char* L, int it0, const Params& p, const bf16_t* __restrict__ U, bf16_t* __restrict__ Gd, const float* __restrict__ SO, const float* __restrict__ SML) {
    constexpr int g_begin = 1;
    constexpr int ldu = 8704;
    const int tid = otid(), wid = tid >> 6, lane = tid & 63, r32 = lane & 31, hi = lane >> 5;
    const float2* cs128 = (const float2*)(p.ws + WS_CS128);
    for (int it = it0; it < 192; it += gridDim.x) {
        const int rr = it & 7, gq = it >> 3, hg = gq % 6, b = gq / 6;
        const int i = 32 * wid + r32, tq = rr + 8 * i, tql = rr + 8 * 32 * wid, tqh = tql + 8 * 31, mytok = b * SEQ + tq;
        f32x16 o[4] = {}; float m_reg = -1e30f, l_reg = 0.f;
        if (g_begin) {
            const float* so = SO + ((size_t)(b * SEQ + rr) * 6 + hg) * 128;
#pragma unroll
            for (int r = 0; r < 16; ++r) { const unsigned off = (unsigned)(8 * (32 * wid + crow(r, hi)) * 768 + r32);
#pragma unroll
                for (int d0 = 0; d0 < 4; ++d0) o[d0][r] = so[off + 32u * d0]; }
            const float* ml = SML + ((size_t)mytok * 6 + hg) * 2; m_reg = ml[0]; l_reg = ml[1];
        }
        for (int g = g_begin; g < 3; ++g) {
            const int hd = g * 6 + hg;
            bf16x8 qr[12];
            const int t2 = otid(), mytok2 = b * SEQ + rr + 8 * (32 * (t2 >> 6) + (t2 & 31));
            load_q<K_DIL>(qr, U + (size_t)mytok2 * ldu + hd * 128, cs128 + (size_t)mytok2 * 64, nullptr, (t2 >> 5) & 1, 0.088388347648318440f * LOG2E);
            const bf16_t* Kp = U + (size_t)(b * SEQ) * ldu + 2304 + hd * 128;
            const int kts = (g == 1) ? 4 : 8, kt0 = (g == 1) ? (rr & 3) : rr;
            const int ntile = (g == 1) ? 8 : 4, wtok = (g == 1) ? 512 : 2048, dmask = (g == 2) ? 15 : 0;
            attn_segment<K_DIL>(L, o, m_reg, l_reg, qr, Kp, Kp + 2304, ldu, ldu, nullptr, 0, kt0, kts, 0, ntile, tq, tql, tqh, wtok, dmask, 0.088388347648318440f * LOG2E, nullptr);
        }
        attn_epilogue(L, o, l_reg, b * SEQ + rr, 8, U + 7424 + hg * 128, ldu, Gd + hg * 128, 1280);
    }
}


#define XB_TMO      128
#define XB_XCNT(j)  (256  + 64 * (j))
#define XB_XSUB(j)  (1280 + 64 * (j))
#define XB_XGEN(j)  (2304 + 64 * (j))
#define XB_TOP      3328
#define XB_TOPGEN   3392
#define XCD_BAR_WORDS 3456
#define XB_SPIN_CAP (1u << 18)
__device__ __forceinline__ unsigned xb_ld(unsigned* p)              { return __hip_atomic_load(p, __ATOMIC_RELAXED, __HIP_MEMORY_SCOPE_AGENT); }
__device__ __forceinline__ unsigned xb_add(unsigned* p, unsigned v) { return __hip_atomic_fetch_add(p, v, __ATOMIC_RELAXED, __HIP_MEMORY_SCOPE_AGENT); }
__device__ __forceinline__ unsigned xb_xcc_id() { return (unsigned)__builtin_amdgcn_s_getreg((3 << 11) | 20) & 0xFu; }
#define XB_SPIN(cond, bar) do { unsigned _sp = 0; while (cond) { __builtin_amdgcn_s_sleep(1); \
    if ((++_sp & 255u) == 0u) { if (xb_ld(&(bar)[XB_TMO])) break; if (_sp > XB_SPIN_CAP) { atomicAdd(&(bar)[XB_TMO], 1u); break; } } } } while (0)
struct XcdBarrier { unsigned* bar; unsigned x; volatile LAS unsigned* st; };
__device__ __forceinline__ XcdBarrier xcd_barrier_post(unsigned* bar, volatile LAS unsigned* st) {
    XcdBarrier b; b.bar = bar; b.x = xb_xcc_id(); b.st = st;
    if (threadIdx.x == 0) (void)xb_add(&bar[XB_XCNT(b.x)], 1u);
    return b;
}
__device__ __forceinline__ void xcd_barrier_complete(unsigned* bar, unsigned x, unsigned& nloc, unsigned& nx) {
    const unsigned G = gridDim.x * gridDim.y * gridDim.z;
    unsigned sum, cnt, mine, sp = 0u;
    for (;;) {
        sum = 0u; cnt = 0u; mine = 0u;
#pragma unroll
        for (unsigned j = 0; j < 16; ++j) { const unsigned c = xb_ld(&bar[XB_XCNT(j)]); sum += c; cnt += (c > 0u) ? 1u : 0u; mine = (j == x) ? c : mine; }
        if (sum == G) break;
        __builtin_amdgcn_s_sleep(1);
        if ((++sp & 255u) == 0u) { if (xb_ld(&bar[XB_TMO])) break; if (sp > XB_SPIN_CAP) { atomicAdd(&bar[XB_TMO], 1u); break; } }
    }
    nloc = mine > 0u ? mine : 1u; nx = cnt > 0u ? cnt : 1u;
}
__device__ __forceinline__ void xcd_census(const XcdBarrier& b) {
    const int tid_c = otid();
    if (tid_c < 64) {
        const unsigned lane = (unsigned)tid_c, G = gridDim.x * gridDim.y * gridDim.z;
        unsigned c = 0u, sum = 0u, sp = 0u;
        for (;;) {
            c = (lane < 16u) ? xb_ld(&b.bar[XB_XCNT(lane)]) : 0u;
            sum = c;
#pragma unroll
            for (int o = 32; o >= 1; o >>= 1) sum += __shfl_xor(sum, o);
            if (sum == G) break;
            __builtin_amdgcn_s_sleep(1);
            if ((++sp & 255u) == 0u) { if (xb_ld(&b.bar[XB_TMO])) break; if (sp > XB_SPIN_CAP) { if (lane == 0) atomicAdd(&b.bar[XB_TMO], 1u); break; } }
        }
        const unsigned cnt = (unsigned)__builtin_popcountll(__ballot(c > 0u));
        const unsigned mine = (unsigned)__shfl((int)c, (int)b.x);
        if (lane == 0) { b.st[0] = mine > 0u ? mine : 1u; b.st[1] = cnt > 0u ? cnt : 1u; }
    }
}
__device__ __forceinline__ void xcd_barrier(const XcdBarrier& b) {
    asm volatile("s_waitcnt vmcnt(0)" ::: "memory");
    __syncthreads();
    if (threadIdx.x == 0) {
        unsigned* bar = b.bar;
        __builtin_amdgcn_s_waitcnt(0);
        unsigned nloc = b.st[0], nx = b.st[1];
        if (nloc == 0u) { xcd_barrier_complete(bar, b.x, nloc, nx); b.st[0] = nloc; b.st[1] = nx; }
        const unsigned old = xb_add(&bar[XB_XSUB(b.x)], 1u);
        const unsigned gen = old / nloc;
        if (old + 1u == (gen + 1u) * nloc) {
            __builtin_amdgcn_fence(__ATOMIC_RELEASE, "agent");
            asm volatile("s_waitcnt vmcnt(0)" ::: "memory");
            const unsigned og = xb_add(&bar[XB_TOP], 1u);
            const unsigned tg = og / nx;
            if (og + 1u == (tg + 1u) * nx) xb_add(&bar[XB_TOPGEN], 1u);
            else XB_SPIN(xb_ld(&bar[XB_TOPGEN]) == tg, bar);
            __builtin_amdgcn_fence(__ATOMIC_ACQUIRE, "agent");
            xb_add(&bar[XB_XGEN(b.x)], 1u);
            asm volatile("s_waitcnt vmcnt(0)" ::: "memory");
        } else {
            XB_SPIN(xb_ld(&bar[XB_XGEN(b.x)]) == gen, bar);
            __builtin_amdgcn_fence(__ATOMIC_ACQUIRE, "agent");
            asm volatile("s_waitcnt vmcnt(0)" ::: "memory");
        }
    }
    __syncthreads();
}


struct CvtSeg { int in_idx, gain_idx, ldsrc, K, dsel, src0, dst0, len; };
__constant__ CvtSeg kSegs[25] = {
    {4, 3, 9232, 2048, 0, 0, 0, 6144}, {4, 3, 9232, 2048, 0, 6144, 9216, 16}, {4, 3, 9232, 2048, 0, 6160, 6144, 512}, {4, 3, 9232, 2048, 0, 6672, 6656, 2560},
    {8, -1, 2048, 2560, 1, 0, 0, 2048},
    {7, 6, 1024, 2048, 2, 0, 0, 1024}, {12, 11, 1024, 2048, 2, 0, 1024, 1024}, {17, 16, 1024, 2048, 2, 0, 2048, 1024}, {26, 25, 1024, 2048, 2, 0, 3072, 1024},
    {22, 21, 3072, 512, 3, 0, 0, 3072}, {24, 23, 4096, 512, 4, 0, 0, 4096},
    {10, 9, 6480, 2048, 0, 0, 0, 2304}, {10, 9, 6480, 2048, 0, 2304, 2304, 1024}, {10, 9, 6480, 2048, 0, 3328, 6400, 64}, {10, 9, 6480, 2048, 0, 3392, 6528, 16},
    {10, 9, 6480, 2048, 0, 3408, 3328, 512}, {10, 9, 6480, 2048, 0, 3920, 3840, 2560}, {13, -1, 2048, 2560, 1, 0, 0, 2048},
    {15, 14, 8704, 2048, 0, 0, 0, 8704}, {18, -1, 2048, 1280, 1, 0, 0, 2048},
    {20, 19, 4160, 2048, 0, 0, 0, 1024}, {20, 19, 4160, 2048, 0, 1024, 4096, 64}, {20, 19, 4160, 2048, 0, 1088, 1024, 512}, {20, 19, 4160, 2048, 0, 1600, 1536, 2560},
    {27, -1, 2048, 2560, 1, 0, 0, 2048}};
__device__ __forceinline__ size_t seg_doff(const CvtSeg& sg, int si) {
    const int par = (si >= 20) ? 1 : (si >= 18 ? 0 : (si >= 11 ? 1 : 0));
    return (sg.dsel == 0) ? WS_WT_IN + par * WT_IN_BYTES : (sg.dsel == 1 ? WS_WT_OUT + par * WT_OUT_BYTES : (sg.dsel == 2 ? WS_WT_MKV : (sg.dsel == 3 ? WS_WT_UQ : WS_WT_UKV)));
}

__global__ void __launch_bounds__(512, 2) fwd_mega(Params p) {
    extern __shared__ __attribute__((aligned(16))) unsigned char lds_raw[];
    LAS unsigned char* L = (LAS unsigned char*)lds_raw;
    cg::grid_group grid = cg::this_grid();
    const int G = gridDim.x, bid = blockIdx.x;
#define WT_IN ((bf16_t*)(p.ws + WS_WT_IN))
#define WT_OUT ((bf16_t*)(p.ws + WS_WT_OUT))
#define WT_UQ ((bf16_t*)(p.ws + WS_WT_UQ))
#define WT_UKV ((bf16_t*)(p.ws + WS_WT_UKV))
#define WT_MKV ((bf16_t*)(p.ws + WS_WT_MKV))
#define HG ((bf16_t*)(p.ws + WS_HG))
#define U ((bf16_t*)(p.ws + WS_U))
#define Q3 ((bf16_t*)(p.ws + WS_Q3))
#define KV3 ((bf16_t*)(p.ws + WS_KV3))
#define MEMN ((bf16_t*)(p.ws + WS_MEMN))
#define MKV ((bf16_t*)(p.ws + WS_MKV))
#define CQ ((bf16_t*)(p.ws + WS_CQ))
#define CKV ((bf16_t*)(p.ws + WS_CKV))
#define MASK ((unsigned*)(p.ws + WS_MASK))
#define CS128 ((float2*)(p.ws + WS_CS128))
#define CS64 ((float2*)(p.ws + WS_CS64))
#define HB ((bf16_t*)(p.ws + WS_HB))
#define SSQ ((float*)(p.ws + WS_SSQ))
    LAS float* T = (LAS float*)L;
    float* xb = p.out;
    volatile LAS unsigned* xst = (volatile LAS unsigned*)(L + LDS_BYTES - 16);
    if (threadIdx.x == 0) { xst[0] = 0u; xst[1] = 0u; xst[2] = 0u; xst[3] = 0u; }
    __syncthreads();
    const XcdBarrier xbar = xcd_barrier_post((unsigned*)(p.ws + WS_BAR), xst);
    if (p.out == nullptr) grid.sync();

    for (int l = 0; l < 4; ++l) {
        if (l == 0) {
            for (int rep = 0; rep < REP_PREP; ++rep) {
                int base = 0;
                for (int si = 0; si < 18; ++si) {
                    if (G == 256 && (si == 4 || si == 9 || si == 10 || si == 16 || si == 17)) continue;
                    const CvtSeg sg = kSegs[si];
                    const size_t doff = seg_doff(sg, si);
                    base = cvt_seg(p.in[sg.in_idx], sg.ldsrc, sg.K, sg.gain_idx >= 0 ? p.in[sg.gain_idx] : nullptr, (bf16_t*)(p.ws + doff), sg.src0, sg.dst0, sg.len, base, T, bid, G);
                }
                rope_tables((const int*)p.in[2], CS128, CS64);
                norm_rows(p.in[1], MEMN, 1024);
                norm_rows(p.in[0], HG, NTOK);
            }
            xcd_census(xbar);
            GSYNC();
        }
        {
            const int npad = (l == 0) ? 9472 : (l == 1 ? 6656 : (l == 2 ? 8704 : 4352));
            const int njobs = (l == 0) ? 2 : 1;
            for (int job = 0; job < njobs * REP_GEMM; ++job) {
                pg8::Gemm g; pg8::EpiBf16 E; pg8::StaticOrder S;
                if (job % njobs == 0) { const int ncols = (l == 3) ? 4096 : npad; g.A = (l == 0) ? HG : HB; g.Bt = WT_IN + (size_t)(l & 1) * (WT_IN_BYTES / 2); g.M = NTOK; g.N = ncols; g.K = 2048; E.O = U; E.ldc = npad; E.ssq = (l == 0) ? nullptr : SSQ; S.init(NTOK, ncols, G, bid); }
                else { g.A = MEMN; g.Bt = WT_MKV; g.M = 1024; g.N = 4096; g.K = 2048; E.O = MKV; E.ldc = 4096; E.ssq = nullptr; S.init(1024, 4096, G, (bid + 64) % G); }
                pg8::gemm_phase<pg8::EpiBf16>(L, g, S, E);
            }
            if (l == 3) krope_gemm(L, HB, WT_IN + (size_t)(l & 1) * (WT_IN_BYTES / 2) + (size_t)4096 * 2048, SSQ, U);
            if (G == 256 && l < 3) {
                const int vb0 = (l == 0) ? 160 : 64, nvb = (l == 0) ? 32 : 192;
                if (bid >= vb0 && bid < vb0 + nvb) {
                    int base = 0;
                    for (int part = 0; part < 2; ++part) {
                        const int lo = part ? ((l == 2) ? 9 : 0) : ((l == 0) ? 16 : (l == 1 ? 18 : 20)), hi2 = part ? ((l == 2) ? 11 : 0) : ((l == 0) ? 17 : (l == 1 ? 20 : 25));
                        for (int si = lo; si < hi2; ++si) {
                            const CvtSeg sg = kSegs[si];
                            base = cvt_seg(p.in[sg.in_idx], sg.ldsrc, sg.K, sg.gain_idx >= 0 ? p.in[sg.gain_idx] : nullptr, (bf16_t*)(p.ws + seg_doff(sg, si)), sg.src0, sg.dst0, sg.len, base, T, bid - vb0, nvb);
                        }
                    }
                }
            }
        }
        GSYNC();
        if (l == 1) { fix_l1(U, CS128, CS64); GSYNC(); for (int rep = 0; rep < REP_IDX; ++rep) phase_indexer(U, CS64, MASK); GSYNC(); }
        if (l == 2) { fix_l2(U, CS128); GSYNC(); }
        if (l == 3) {
            fix_l3(U, CQ, CKV, CS64); GSYNC();
            for (int job = 0; job < 2 * REP_UQ; ++job) {
                pg8::Gemm g; pg8::EpiBf16 E; pg8::StaticOrder S;
                E.ssq = nullptr;
                if ((job & 1) == 0) { g.A = CQ; g.Bt = WT_UQ; g.M = NTOK; g.N = 3072; g.K = 512; E.O = Q3; E.ldc = 3072; S.init(NTOK, 3072, G, bid); }
                else { g.A = CKV; g.Bt = WT_UKV; g.M = NTOK; g.N = 4096; g.K = 512; E.O = KV3; E.ldc = 4096; S.init(NTOK, 4096, G, bid); }
                pg8::gemm_phase<pg8::EpiBf16>(L, g, S, E);
            }
            if (G == 256 && bid >= 128) mem_items(L, bid - 128, G, U, 4352, 1024, 1536 + 2048, MKV, 3, HG, 2560, 2048);
            GSYNC();
        }
        for (int rep = 0; rep < ((l == REP_ATTN_L) ? 2 : REP_ATTN); ++rep) {
            const int ldu = (l == 0) ? 9472 : (l == 1 ? 6656 : (l == 2 ? 8704 : 4352));
            const int qcol = (l == 0) ? 6144 : (l == 1 ? 3328 : (l == 2 ? 6912 : 1024));
            const int zcol = (l == 0) ? 6656 + 2048 : (l == 1 ? 3840 + 2048 : (l == 2 ? 7424 + 768 : 1536 + 2048));
            const int nmain = (l == 2) ? 192 : 256;
            { const int i = bid * 512 + otid(); if (i < NTOK) SSQ[i] = 0.f; }
            {
                const bool slot0 = (G == 256 && (l == 0 || l == 1) && bid >= 128), fb = (G != 256 && (l == 1 || l == 2));
                if (rep == 0 && (slot0 || fb)) {
                    int base = 0; const int lo = slot0 ? (l == 0 ? 4 : 17) : (l == 1 ? 18 : 20), hi2 = slot0 ? (l == 0 ? 5 : 18) : (l == 1 ? 20 : 25);
                    for (int si = lo; si < hi2; ++si) { const CvtSeg sg = kSegs[si];
                        base = cvt_seg(p.in[sg.in_idx], sg.ldsrc, sg.K, sg.gain_idx >= 0 ? p.in[sg.gain_idx] : nullptr, (bf16_t*)(p.ws + seg_doff(sg, si)), sg.src0, sg.dst0, sg.len, base, T, slot0 ? bid - 128 : bid, slot0 ? 128 : G); } }
            }
            const int xr = bid & 7, xs = bid >> 3;
            const int itc = (G == 256) ? xr * 32 + xs : bid;
            int itd = bid, itm = bid;
            if (G == 256) { itd = (xs < 24) ? (((xs >> 3) * 8 + xr) * 8 + (xs & 7)) : 192; itm = (l == 2) ? ((xs >= 24) ? (xs - 24) * 8 + xr : 128) : bid; }
            if (l == 0) causal_items<K_FOX>(L, itc, p, U, 9472, HG);
            else if (l == 1) causal_items<K_DSA>(L, itc, p, U, 6656, HG);
            else if (l == 2) dilA_items(L, itd, p, U, (float*)(p.ws + WS_WT_IN), (float*)(p.ws + WS_WT_IN) + (size_t)NTOK * 768);
            else causal_items<K_MLA>(L, itc, p, U, 4352, HG);
            if (!(l == 3 && G == 256))
            mem_items(L, itm, (l == 2 && G == 256) ? 64 : G, U, ldu, qcol, zcol, MKV, l, HG, (l == 2) ? 1280 : 2560, (l == 2) ? 768 : 2048);
        }
        GSYNC();
        if (l == 2) {
            const int xr = bid & 7, xs = bid >> 3; const int itd = (G == 256) ? ((xs < 24) ? (((xs >> 3) * 8 + xr) * 8 + (xs & 7)) : 192) : bid;
            dil_items(L, itd, p, U, HG, (const float*)(p.ws + WS_WT_IN), (const float*)(p.ws + WS_WT_IN) + (size_t)NTOK * 768);
            GSYNC();
        }
        {
            pg8::Gemm g; pg8::EpiResid E; pg8::StaticOrder S;
            g.A = HG; g.Bt = WT_OUT + (size_t)(l & 1) * (WT_OUT_BYTES / 2); g.M = NTOK; g.N = 2048; g.K = (l == 2) ? 1280 : 2560;
            E.xin = (l == 0) ? p.in[0] : xb; E.xout = xb; E.hout = HB; E.ssq = SSQ; S.init(NTOK, 2048, G, bid);
            pg8::gemm_phase<pg8::EpiResid>(L, g, S, E);
        }
        GSYNC();
    }
    final_norm(xb, p.in[28]);
}

#undef WT_IN
#undef WT_OUT
#undef WT_UQ
#undef WT_UKV
#undef WT_MKV
#undef HG
#undef U
#undef Q3
#undef KV3
#undef MEMN
#undef MKV
#undef CQ
#undef CKV
#undef MASK
#undef CS128
#undef CS64
#undef HB
#undef SSQ

extern "C" void kernel_launch(void* const* d_in, const int* in_sizes, int n_in, void* d_out, int out_size, void* d_ws, size_t ws_size, hipStream_t stream) {
    static int grid = 0;
    if (grid == 0) {
        int dev = 0, cus = 0, per_cu = 0;
        hipGetDevice(&dev);
        hipDeviceGetAttribute(&cus, hipDeviceAttributeMultiprocessorCount, dev);
        hipFuncSetAttribute((const void*)fwd_mega, hipFuncAttributeMaxDynamicSharedMemorySize, LDS_BYTES);
        hipOccupancyMaxActiveBlocksPerMultiprocessor(&per_cu, (const void*)fwd_mega, 512, LDS_BYTES);
        (void)hipGetLastError();
        grid = cus;
        if (ws_size < WS_END || n_in != 29 || cus < 16) { fprintf(stderr, "kernel_launch: ws %zu < %zu or n_in %d != 29\n", ws_size, (size_t)WS_END, n_in); grid = -1; }
    }
    if (grid < 0) return;
    Params p{};
    for (int i = 0; i < n_in && i < 32; ++i) p.in[i] = (const float*)d_in[i];
    p.out = (float*)d_out; p.ws = (unsigned char*)d_ws;
    hipMemsetAsync((unsigned char*)d_ws + WS_BAR, 0, BAR_BYTES, stream);
    void* args[] = {&p};
    hipError_t e = hipLaunchCooperativeKernel((const void*)fwd_mega, dim3(grid), dim3(512), args, LDS_BYTES, stream);
    if (e != hipSuccess) fprintf(stderr, "cooperative launch failed: %s (grid %d)\n", hipGetErrorString(e), grid);
}
```

```cpp
#include <hip/hip_runtime.h>
#include <hip/hip_cooperative_groups.h>
#include <cstdio>
#include <cstdint>
namespace cg = cooperative_groups;

#define LAS __attribute__((address_space(3)))
typedef unsigned short bf16_t;
typedef short bf16x8 __attribute__((ext_vector_type(8)));
typedef short s16x4 __attribute__((ext_vector_type(4)));
typedef float f32x4 __attribute__((ext_vector_type(4)));
typedef float f32x16 __attribute__((ext_vector_type(16)));
typedef unsigned u32x4 __attribute__((ext_vector_type(4)));

constexpr int NB = 4, SEQ = 2048, NTOK = NB * SEQ, DM = 2048;
constexpr int LDS_BYTES = 160 * 1024;
constexpr float LOG2E = 1.4426950408889634f;
#ifndef REP_SYNC
#define REP_SYNC 1
#endif
#ifndef REP_ATTN
#define REP_ATTN 1
#endif
#ifndef REP_GEMM
#define REP_GEMM 1
#endif
#ifndef REP_PREP
#define REP_PREP 1
#endif
#ifndef REP_ATTN_L
#define REP_ATTN_L 9
#endif
#ifndef REP_UQ
#define REP_UQ 1
#endif
#ifndef REP_IDX
#define REP_IDX 1
#endif
#define GSYNC() do { for (int _r = 0; _r < REP_SYNC; ++_r) xcd_barrier(xbar); } while (0)

constexpr size_t WT_IN_BYTES = (size_t)9472 * 2048 * 2, WT_OUT_BYTES = (size_t)2048 * 2560 * 2;
constexpr size_t WS_WT_IN = 0;
constexpr size_t WS_WT_OUT = WS_WT_IN + 2 * WT_IN_BYTES;
constexpr size_t WS_WT_UQ = WS_WT_OUT + 2 * WT_OUT_BYTES;
constexpr size_t WS_WT_UKV = WS_WT_UQ + (size_t)3072 * 512 * 2;
constexpr size_t WS_WT_MKV = WS_WT_UKV + (size_t)4096 * 512 * 2;
constexpr size_t WS_HG = WS_WT_MKV + (size_t)4096 * 2048 * 2;
constexpr size_t WS_U = WS_HG + (size_t)NTOK * 2560 * 2;
constexpr size_t U3_BYTES = (size_t)NTOK * 4352 * 2, Q3_BYTES = (size_t)NTOK * 3072 * 2, KV3_BYTES = (size_t)NTOK * 4096 * 2;
constexpr size_t WS_Q3 = WS_U + U3_BYTES;
constexpr size_t WS_KV3 = WS_Q3 + Q3_BYTES;
constexpr size_t WS_MEMN = WS_KV3 + KV3_BYTES;
constexpr size_t WS_MKV = WS_MEMN + (size_t)1024 * 2048 * 2;
constexpr size_t WS_CQ = WS_MKV + (size_t)1024 * 4096 * 2;
constexpr size_t WS_CKV = WS_CQ + (size_t)NTOK * 512 * 2;
constexpr size_t WS_MASK = WS_CKV + (size_t)NTOK * 512 * 2;
constexpr size_t WS_CS128 = WS_MASK + (size_t)NTOK * 64 * 4;
constexpr size_t WS_CS64 = WS_CS128 + (size_t)NTOK * 64 * 8;
constexpr size_t WS_SSQ = WS_CS64 + (size_t)NTOK * 32 * 8;
constexpr size_t WS_BAR = WS_SSQ + (size_t)NTOK * 4;
constexpr size_t BAR_BYTES = 16384;
constexpr size_t WS_END = WS_BAR + BAR_BYTES;
static_assert(WS_U + (size_t)NTOK * 9472 * 2 <= WS_MEMN, "U0 must fit the U region");
constexpr size_t WS_HB = WS_U + (size_t)144 * 1024 * 1024;
static_assert(WS_HB + (size_t)NTOK * 2048 * 2 <= WS_MEMN && (size_t)NTOK * 8704 * 2 <= (size_t)144 * 1024 * 1024, "HB placement");

struct Params {
    const float* in[32];
    float* out;
    unsigned char* ws;
};

__device__ __forceinline__ int otid() { int t = threadIdx.x; asm volatile("" : "+v"(t)); return t; }
__device__ __forceinline__ float bf2f(short s) { return __uint_as_float(((unsigned)(unsigned short)s) << 16); }
__device__ __forceinline__ float bfu2f(bf16_t s) { return __uint_as_float(((unsigned)s) << 16); }
__device__ __forceinline__ unsigned cvtpk(float lo, float hi) { unsigned r; asm volatile("v_cvt_pk_bf16_f32 %0, %1, %2" : "=v"(r) : "v"(lo), "v"(hi)); return r; }
__device__ __forceinline__ bf16_t f2bf(float f) { return (bf16_t)(cvtpk(f, f) & 0xffffu); }
__device__ __forceinline__ bf16x8 pack8(const float* a) { u32x4 w = {cvtpk(a[0], a[1]), cvtpk(a[2], a[3]), cvtpk(a[4], a[5]), cvtpk(a[6], a[7])}; return __builtin_bit_cast(bf16x8, w); }

namespace pg8 {
constexpr int BM = 256, BK = 64, HALF = 128, HTB = HALF * BK * 2, STAGE_BYTES = 8 * HTB, NXCD = 8, WGM = 8;
__device__ __forceinline__ int lds_byte(int r, int c) { const int st = (r >> 4) * 2 + (c >> 5), rr = r & 15, cc = c & 31, ob = rr * 64 + cc * 2; return st * 1024 + (ob ^ (((ob >> 9) & 1) << 5)); }
__device__ __forceinline__ void stage_rc(int b, int& R, int& C) { const int st = b / 1024, sb = b % 1024, swz = sb ^ (((sb >> 9) & 1) << 5); R = (st >> 1) * 16 + swz / 64; C = (st & 1) * 32 + (swz % 64) / 2; }
__device__ __forceinline__ int perm32(int rho) { const int n = rho >> 4, i = rho & 15; return 8 * (i >> 2) + 4 * n + (i & 3); }
struct Unit { int pm, pn; };
struct Gemm { const bf16_t* A; const bf16_t* Bt; int M, N, K; };
struct StaticOrder {
    int nM, nN, nwg, G, c;
    __device__ void init(int M, int N, int G_, int c_) { nM = M / BM; nN = N / BM; nwg = nM * nN; G = G_; c = c_; }
    __device__ bool next(int i, Unit& u) const {
        const long L = (long)i * G + c; if (L >= nwg) return false;
        int wgid = (int)L; { const int q = nwg / NXCD, r = nwg % NXCD, xcd = wgid % NXCD, off = wgid / NXCD; wgid = (xcd < r ? xcd * (q + 1) : r * (q + 1) + (xcd - r) * q) + off; }
        const int nig = WGM * nN, gid = wgid / nig, fm = gid * WGM, gsz = (nM - fm) < WGM ? (nM - fm) : WGM;
        u.pm = fm + ((wgid % nig) % gsz); u.pn = (wgid % nig) / gsz; return true;
    }
};
struct EpiBf16 {
    static constexpr bool PERM = true;
    __device__ __forceinline__ void preload(float (&pre)[8], const Unit& u, int wr, int fr) const {
        const int row0 = u.pm * BM + wr * 64 + fr;
#pragma unroll
        for (int ai = 0; ai < 2; ++ai)
#pragma unroll
            for (int m = 0; m < 4; ++m) pre[ai * 4 + m] = ssq ? ssq[row0 + ai * HALF + m * 16] : 0.f; }
    bf16_t* O; int ldc; const float* ssq;
    __device__ __forceinline__ void operator()(const f32x4 (&acc)[2][2][4][2], const Unit& u, int wr, int wc, int fr, int fq, const float (&pre)[8]) const {
        const int row0 = u.pm * BM + wr * 64 + fr, col0 = u.pn * BM + wc * 32 + 8 * fq;
        float rsv[2][4];
#pragma unroll
        for (int ai = 0; ai < 2; ++ai)
#pragma unroll
            for (int m = 0; m < 4; ++m) rsv[ai][m] = pre[ai * 4 + m];
#pragma unroll
        for (int ai = 0; ai < 2; ++ai)
#pragma unroll
            for (int m = 0; m < 4; ++m) { const int row = row0 + ai * HALF + m * 16; bf16_t* rowp = O + (size_t)row * ldc + col0;
                const float rs = ssq ? rsqrtf(rsv[ai][m] * (1.0f / DM) + 1e-6f) : 1.0f;
#pragma unroll
                for (int bj = 0; bj < 2; ++bj) { const f32x4 v0 = acc[ai][bj][m][0] * rs, v1 = acc[ai][bj][m][1] * rs;
                    u32x4 w = {cvtpk(v0[0], v0[1]), cvtpk(v0[2], v0[3]), cvtpk(v1[0], v1[1]), cvtpk(v1[2], v1[3])};
                    *(u32x4*)(rowp + bj * HALF) = w; } }
    }
};
struct EpiResid {
    static constexpr bool PERM = false;
    const float* xin; float* xout; bf16_t* hout; float* ssq;
    __device__ __forceinline__ void preload(float (&)[8], const Unit&, int, int) const {}
    __device__ __forceinline__ void operator()(const f32x4 (&acc)[2][2][4][2], const Unit& u, int wr, int wc, int fr, int fq, const float (&)[8]) const {
        const int row0 = u.pm * BM + wr * 64 + fr, col0 = u.pn * BM + wc * 32 + 4 * fq;
        f32x4 xa[8], xb[8];
#define ER_LOAD(X, b) do { _Pragma("unroll") for (int mm = 0; mm < 2; ++mm) _Pragma("unroll") for (int q = 0; q < 4; ++q) \
            X[mm * 4 + q] = *(const f32x4*)(xin + (size_t)(row0 + ((b) >> 1) * HALF + (((b) & 1) * 2 + mm) * 16) * DM + col0 + (q >> 1) * HALF + (q & 1) * 16); } while (0)
#define ER_STORE(X, b) do { _Pragma("unroll") for (int mm = 0; mm < 2; ++mm) { const int ai = (b) >> 1, m = ((b) & 1) * 2 + mm; const int row = row0 + ai * HALF + m * 16; float ss = 0.f; \
            _Pragma("unroll") for (int q = 0; q < 4; ++q) { const size_t idx = (size_t)row * DM + col0 + (q >> 1) * HALF + (q & 1) * 16; const f32x4 x = X[mm * 4 + q] + acc[ai][q >> 1][m][q & 1]; \
                *(f32x4*)(xout + idx) = x; ss += x[0] * x[0] + x[1] * x[1] + x[2] * x[2] + x[3] * x[3]; \
                uint2 hw = make_uint2(cvtpk(x[0], x[1]), cvtpk(x[2], x[3])); *(uint2*)(hout + idx) = hw; } \
            ss += __shfl_xor(ss, 16); ss += __shfl_xor(ss, 32); if (fq == 0) atomicAdd(ssq + row, ss); } } while (0)
        ER_LOAD(xa, 0);
        ER_LOAD(xb, 1); ER_STORE(xa, 0);
        ER_LOAD(xa, 2); ER_STORE(xb, 1);
        ER_LOAD(xb, 3); ER_STORE(xa, 2);
        ER_STORE(xb, 3);
#undef ER_LOAD
#undef ER_STORE
    }
};

template <class Epi>
__device__ __forceinline__ void gemm_phase(LAS unsigned char* lds, const Gemm g, const StaticOrder& S, const Epi& E) {
    const int tid = otid(), wid = __builtin_amdgcn_readfirstlane(tid >> 6), lane = tid & 63, wr = wid >> 2, wc = wid & 3, fr = lane & 15, fq = lane >> 4;
    const int K = g.K, nt = K / BK;
    unsigned voffA[2], voffB[2];
#pragma unroll
    for (int i = 0; i < 2; ++i) { int R, C; stage_rc(tid * 16 + i * 8192, R, C); const int Rb = Epi::PERM ? ((R & ~31) + perm32(R & 31)) : R;
        voffA[i] = (unsigned)(R * K + C) * 2u; voffB[i] = (unsigned)(Rb * K + C) * 2u; }
    const size_t kstep = (size_t)(BK * 2);
    const size_t hstep = (size_t)HALF * K * 2;
    const size_t tstep = 2 * hstep;
    const unsigned ldsw = (unsigned)wid * 1024u;
    const int aoff = lds_byte(wr * 64 + fr, fq * 8), boff = lds_byte(wc * 32 + fr, fq * 8);
#define PG8_SA(b, h) (((b) * 2 + (h)) * HTB)
#define PG8_SB(b, h) ((4 + (b) * 2 + (h)) * HTB)
#define PG8_STAGE(bufoff, gbase, voff) do { _Pragma("unroll") for (int _i = 0; _i < 2; ++_i) \
        __builtin_amdgcn_global_load_lds((const unsigned*)((const char*)(gbase) + (voff)[_i]), (LAS unsigned*)(lds + (bufoff) + ldsw + _i * 8192), 16, 0, 0); } while (0)
#define PG8_LDA(dst, b, h) do { _Pragma("unroll") for (int m = 0; m < 4; ++m) _Pragma("unroll") for (int k = 0; k < 2; ++k) dst[m][k] = *(const LAS bf16x8*)(lds + PG8_SA(b, h) + aoff + m * 2048 + k * 1024); } while (0)
#define PG8_LDB(dst, b, h) do { _Pragma("unroll") for (int n = 0; n < 2; ++n) _Pragma("unroll") for (int k = 0; k < 2; ++k) dst[n][k] = *(const LAS bf16x8*)(lds + PG8_SB(b, h) + boff + n * 2048 + k * 1024); } while (0)
#define PG8_MMA(ai, bj, At, Bt) do { __builtin_amdgcn_s_setprio(1); _Pragma("unroll") for (int m = 0; m < 4; ++m) _Pragma("unroll") for (int n = 0; n < 2; ++n) _Pragma("unroll") for (int k = 0; k < 2; ++k) \
        acc[ai][bj][m][n] = __builtin_amdgcn_mfma_f32_16x16x32_bf16(Bt[n][k], At[m][k], acc[ai][bj][m][n], 0, 0, 0); __builtin_amdgcn_s_setprio(0); } while (0)
#define PG8_WAIT_V(n) asm volatile("s_waitcnt vmcnt(" #n ")" ::: "memory")
#define PG8_WAIT_L(n) asm volatile("s_waitcnt lgkmcnt(" #n ")" ::: "memory")
#define PG8_BAR __builtin_amdgcn_s_barrier()
#define PG8_SCHED __builtin_amdgcn_sched_barrier(0)
    Unit cur, nxt; int ui = 0;
    if (!S.next(0, cur)) return;
    f32x4 acc[2][2][4][2];
#pragma unroll
    for (int a = 0; a < 2; ++a)
#pragma unroll
        for (int b = 0; b < 2; ++b)
#pragma unroll
            for (int m = 0; m < 4; ++m)
#pragma unroll
                for (int n = 0; n < 2; ++n) acc[a][b][m][n] = (f32x4){0.f, 0.f, 0.f, 0.f};
    bf16x8 At[4][2], B0[2][2], B1[2][2];
    float pre[8] = {0.f, 0.f, 0.f, 0.f, 0.f, 0.f, 0.f, 0.f};
    const char* cA = (const char*)g.A + (size_t)cur.pm * tstep; const char* cB = (const char*)g.Bt + (size_t)cur.pn * tstep;
    PG8_STAGE(PG8_SB(0, 0), cB, voffB); PG8_STAGE(PG8_SA(0, 0), cA, voffA); PG8_STAGE(PG8_SB(0, 1), cB + hstep, voffB); PG8_STAGE(PG8_SA(0, 1), cA + hstep, voffA);
    if (wr == 1) PG8_BAR;
    PG8_WAIT_V(4); PG8_BAR;
    PG8_STAGE(PG8_SB(1, 0), cB + kstep, voffB); PG8_STAGE(PG8_SA(1, 0), cA + kstep, voffA); PG8_STAGE(PG8_SB(1, 1), cB + hstep + kstep, voffB);
    PG8_WAIT_V(6); PG8_BAR;
    for (;;) {
        const bool has_next = S.next(ui + 1, nxt);
        const char* nA = has_next ? (const char*)g.A + (size_t)nxt.pm * tstep : cA; const char* nB = has_next ? (const char*)g.Bt + (size_t)nxt.pn * tstep : cB;
        for (int t = 0; t < nt; t += 2) {
            const bool last = (t == nt - 2);
            if (last) E.preload(pre, cur, wr, fr);
            const char* a1 = cA + (size_t)(t + 1) * kstep;
            const char* a2 = last ? nA : cA + (size_t)(t + 2) * kstep; const char* b2 = last ? nB : cB + (size_t)(t + 2) * kstep;
            const char* a3 = a2 + kstep; const char* b3 = b2 + kstep;
            PG8_LDB(B0, 0, 0); PG8_SCHED; PG8_LDA(At, 0, 0); PG8_STAGE(PG8_SA(1, 1), a1 + hstep, voffA);
            PG8_WAIT_L(8); PG8_BAR; PG8_WAIT_L(0); PG8_MMA(0, 0, At, B0); PG8_BAR; PG8_SCHED;
            PG8_LDB(B1, 0, 1); PG8_STAGE(PG8_SB(0, 0), b2, voffB);
            PG8_BAR; PG8_WAIT_L(0); PG8_MMA(0, 1, At, B1); PG8_BAR;
            PG8_LDA(At, 0, 1); PG8_STAGE(PG8_SA(0, 0), a2, voffA);
            PG8_BAR; PG8_WAIT_L(0); PG8_MMA(1, 0, At, B0); PG8_BAR; PG8_SCHED;
            PG8_STAGE(PG8_SB(0, 1), b2 + hstep, voffB);
            PG8_WAIT_V(6); PG8_BAR; PG8_MMA(1, 1, At, B1); PG8_BAR;
            PG8_LDB(B0, 1, 0); PG8_SCHED; PG8_LDA(At, 1, 0); PG8_STAGE(PG8_SA(0, 1), a2 + hstep, voffA);
            PG8_WAIT_L(8); PG8_BAR; PG8_WAIT_L(0); PG8_MMA(0, 0, At, B0); PG8_BAR; PG8_SCHED;
            PG8_LDB(B1, 1, 1); PG8_STAGE(PG8_SB(1, 0), b3, voffB);
            PG8_BAR; PG8_WAIT_L(0); PG8_MMA(0, 1, At, B1); PG8_BAR;
            PG8_LDA(At, 1, 1); PG8_STAGE(PG8_SA(1, 0), a3, voffA);
            PG8_BAR; PG8_WAIT_L(0); PG8_MMA(1, 0, At, B0); PG8_BAR; PG8_SCHED;
            PG8_STAGE(PG8_SB(1, 1), b3 + hstep, voffB);
            PG8_WAIT_V(6); PG8_BAR; PG8_MMA(1, 1, At, B1); PG8_BAR;
        }
        E(acc, cur, wr, wc, fr, fq, pre);
        if (!has_next) break;
#pragma unroll
        for (int a = 0; a < 2; ++a)
#pragma unroll
            for (int b = 0; b < 2; ++b)
#pragma unroll
                for (int m = 0; m < 4; ++m)
#pragma unroll
                    for (int n = 0; n < 2; ++n) acc[a][b][m][n] = (f32x4){0.f, 0.f, 0.f, 0.f};
        cur = nxt; cA = nA; cB = nB; ++ui;
    }
    PG8_WAIT_V(0);
    if (wr == 0) PG8_BAR;
    PG8_BAR;
#undef PG8_SA
#undef PG8_SB
#undef PG8_STAGE
#undef PG8_LDA
#undef PG8_LDB
#undef PG8_MMA
#undef PG8_WAIT_V
#undef PG8_WAIT_L
#undef PG8_BAR
#undef PG8_SCHED
}
}

__device__ __forceinline__ int cvt_seg(const float* __restrict__ src, int ldsrc, int K, const float* __restrict__ gain, bf16_t* __restrict__ dst, int src0, int dst0, int len, int base, LAS float* T, int vbid, int G) {
    const int tid = otid();
    const int ntn = (len + 255) / 256, ntk = K / 64, nt = ntn * ntk;
    const int first = ((vbid - base) % G + G) % G;
    const int kk0 = tid >> 6, n4 = (tid & 63) * 4;
    float4 vA[8], vB[8]; float gA[8], gB[8];
    const float* gp = gain ? gain : src; const float gsel = gain ? 1.f : 0.f, gone = gain ? 0.f : 1.f;
#define CVT_LOAD(v, gv, t) do { const int _tn = (t) / ntk, _tk = (t) % ntk, _n0 = _tn * 256, _k0 = _tk * 64; const int _nv = (len - _n0) < 256 ? (len - _n0) : 256; \
        const int _n4c = (n4 < _nv) ? n4 : 0;     \
        _Pragma("unroll") for (int i = 0; i < 8; ++i) { const int kk = kk0 + 8 * i; \
            v[i] = *(const float4*)(src + (size_t)(_k0 + kk) * ldsrc + src0 + _n0 + _n4c); gv[i] = fmaf(gp[_k0 + kk], gsel, gone); } } while (0)
#define CVT_TILE(v, gv, t) do { const int tn = (t) / ntk, tk = (t) % ntk, n0 = tn * 256, k0 = tk * 64; \
        const int nvalid = (len - n0) < 256 ? (len - n0) : 256; \
        if (n4 < nvalid) { _Pragma("unroll") for (int i = 0; i < 8; ++i) { LAS float* tp = T + (kk0 + 8 * i) * 257 + n4; \
            tp[0] = v[i].x * gv[i]; tp[1] = v[i].y * gv[i]; tp[2] = v[i].z * gv[i]; tp[3] = v[i].w * gv[i]; } } \
        __syncthreads(); \
        if ((t) + 2 * G < nt) CVT_LOAD(v, gv, (t) + 2 * G); \
        _Pragma("unroll") for (int r = 0; r < 4; ++r) { const int i = tid + 512 * r, n = i >> 3, kc = (i & 7) * 8; \
            if (n < nvalid) { float a[8]; _Pragma("unroll") for (int e = 0; e < 8; ++e) a[e] = T[(kc + e) * 257 + n]; \
                *(bf16x8*)(dst + (size_t)(dst0 + n0 + n) * K + k0 + kc) = pack8(a); } } \
        __syncthreads(); } while (0)
    if (first < nt) CVT_LOAD(vA, gA, first);
    if (first + G < nt) CVT_LOAD(vB, gB, first + G);
    for (int t = first; t < nt; t += 2 * G) {
        CVT_TILE(vA, gA, t);
        if (t + G < nt) CVT_TILE(vB, gB, t + G);
    }
#undef CVT_TILE
#undef CVT_LOAD
    return base + nt;
}

__device__ __forceinline__ void norm_rows(const float* __restrict__ x, bf16_t* __restrict__ h, int nrows) {
    const int tid_ = otid(), lane = tid_ & 63, gw = blockIdx.x * 8 + (tid_ >> 6), nw = gridDim.x * 8;
    for (int row = gw; row < nrows; row += nw) {
        const float4* r4 = (const float4*)(x + (size_t)row * DM);
        float4 v[8]; float ss = 0.f;
#pragma unroll
        for (int i = 0; i < 8; ++i) { v[i] = r4[lane * 2 + (i & 1) + 128 * (i >> 1)]; ss += v[i].x * v[i].x + v[i].y * v[i].y + v[i].z * v[i].z + v[i].w * v[i].w; }
#pragma unroll
        for (int o = 32; o >= 1; o >>= 1) ss += __shfl_xor(ss, o);
        const float rstd = rsqrtf(ss * (1.0f / DM) + 1e-6f);
#pragma unroll
        for (int i = 0; i < 4; ++i) { float a[8] = {v[2 * i].x * rstd, v[2 * i].y * rstd, v[2 * i].z * rstd, v[2 * i].w * rstd, v[2 * i + 1].x * rstd, v[2 * i + 1].y * rstd, v[2 * i + 1].z * rstd, v[2 * i + 1].w * rstd};
            *(bf16x8*)(h + (size_t)row * DM + (lane * 2 + 128 * i) * 4) = pack8(a); }
    }
}

__device__ __forceinline__ void final_norm(float* __restrict__ xb, const float* __restrict__ g) {
    const int tid_ = otid(), lane = tid_ & 63, gw = blockIdx.x * 8 + (tid_ >> 6), nw = gridDim.x * 8;
    for (int row = gw; row < NTOK; row += nw) {
        float4* r4 = (float4*)(xb + (size_t)row * DM);
        float4 v[8]; float ss = 0.f;
#pragma unroll
        for (int i = 0; i < 8; ++i) { v[i] = r4[lane + 64 * i]; ss += v[i].x * v[i].x + v[i].y * v[i].y + v[i].z * v[i].z + v[i].w * v[i].w; }
#pragma unroll
        for (int o = 32; o >= 1; o >>= 1) ss += __shfl_xor(ss, o);
        const float rstd = rsqrtf(ss * (1.0f / DM) + 1e-6f);
#pragma unroll
        for (int i = 0; i < 8; ++i) { const float4 gg = ((const float4*)g)[lane + 64 * i];
            float4 o4 = {v[i].x * rstd * gg.x, v[i].y * rstd * gg.y, v[i].z * rstd * gg.z, v[i].w * rstd * gg.w}; r4[lane + 64 * i] = o4; }
    }
}

__device__ __forceinline__ void rope_tables(const int* __restrict__ pos, float2* __restrict__ cs128, float2* __restrict__ cs64) {
    const int tid_ = otid(), lane = tid_ & 63, gw = blockIdx.x * 8 + (tid_ >> 6), nw = gridDim.x * 8;
    const float f128 = powf(10000.0f, -(float)(2 * lane) / 128.0f);
    const float f64 = powf(10000.0f, -(float)(2 * (lane & 31)) / 64.0f);
    for (int tok = gw; tok < NTOK; tok += nw) {
        const float p = (float)pos[tok];
        const float a = p * f128; cs128[(size_t)tok * 64 + lane] = make_float2(cosf(a), sinf(a));
        if (lane < 32) { const float b = p * f64; cs64[(size_t)tok * 32 + lane] = make_float2(cosf(b), sinf(b)); }
    }
}

__device__ __forceinline__ void fix_l1(bf16_t* Ub, const float2* cs128, const float2* cs64) {
    const int tid_ = otid(), lane = tid_ & 63, gw = blockIdx.x * 8 + (tid_ >> 6), nw = gridDim.x * 8;
    for (int t0 = gw; t0 < NTOK; t0 += 2 * nw) {
        bf16_t ka[2], kb[2], ia[2] = {0, 0}, ib[2] = {0, 0}; float2 c1[2], c2[2] = {make_float2(0.f, 0.f), make_float2(0.f, 0.f)};
#pragma unroll
        for (int j = 0; j < 2; ++j) { const int tok = t0 + j * nw; if (tok < NTOK) { bf16_t* row = Ub + (size_t)tok * 6656;
            ka[j] = row[2048 + lane]; kb[j] = row[2048 + 64 + lane]; c1[j] = cs128[(size_t)tok * 64 + lane];
            if (lane < 32) { ia[j] = row[6400 + lane]; ib[j] = row[6400 + 32 + lane]; c2[j] = cs64[(size_t)tok * 32 + lane]; } } }
#pragma unroll
        for (int j = 0; j < 2; ++j) { const int tok = t0 + j * nw; if (tok < NTOK) { bf16_t* row = Ub + (size_t)tok * 6656;
            { const float x1 = bfu2f(ka[j]), x2 = bfu2f(kb[j]); row[2048 + lane] = f2bf(x1 * c1[j].x - x2 * c1[j].y); row[2048 + 64 + lane] = f2bf(x2 * c1[j].x + x1 * c1[j].y); }
            if (lane < 32) { const float x1 = bfu2f(ia[j]), x2 = bfu2f(ib[j]); row[6400 + lane] = f2bf(x1 * c2[j].x - x2 * c2[j].y); row[6400 + 32 + lane] = f2bf(x2 * c2[j].x + x1 * c2[j].y); } } }
    }
}
__device__ __forceinline__ void fix_l2(bf16_t* Ub, const float2* cs128) {
    const int tid_ = otid(), lane = tid_ & 63, gw = blockIdx.x * 8 + (tid_ >> 6), nw = gridDim.x * 8;
    for (int t0 = gw; t0 < NTOK; t0 += 2 * nw) {
        bf16_t a[2][18], b[2][18]; float2 cs[2];
#pragma unroll
        for (int j = 0; j < 2; ++j) { const int tok = t0 + j * nw; if (tok < NTOK) { const bf16_t* row = Ub + (size_t)tok * 8704 + 2304 + lane; cs[j] = cs128[(size_t)tok * 64 + lane];
#pragma unroll
            for (int hh = 0; hh < 18; ++hh) { a[j][hh] = row[hh * 128]; b[j][hh] = row[hh * 128 + 64]; } } }
#pragma unroll
        for (int j = 0; j < 2; ++j) { const int tok = t0 + j * nw; if (tok < NTOK) { bf16_t* row = Ub + (size_t)tok * 8704 + 2304 + lane;
#pragma unroll
            for (int hh = 0; hh < 18; ++hh) { const float x1 = bfu2f(a[j][hh]), x2 = bfu2f(b[j][hh]);
                row[hh * 128] = f2bf(x1 * cs[j].x - x2 * cs[j].y); row[hh * 128 + 64] = f2bf(x2 * cs[j].x + x1 * cs[j].y); } } }
    }
}
__device__ __forceinline__ void fix_l3(bf16_t* Ub, bf16_t* CQb, bf16_t* CKVb, const float2* cs64) {
    const int tid_ = otid(), lane = tid_ & 63, gw = blockIdx.x * 8 + (tid_ >> 6), nw = gridDim.x * 8;
    for (int t0 = gw; t0 < NTOK; t0 += 2 * nw) {
        bf16x8 v[2][2]; bf16_t ra[2] = {0, 0}, rb[2] = {0, 0}; float2 c2[2] = {make_float2(0.f, 0.f), make_float2(0.f, 0.f)};
#pragma unroll
        for (int j = 0; j < 2; ++j) { const int tok = t0 + j * nw; if (tok < NTOK) { const bf16_t* row = Ub + (size_t)tok * 4352;
            v[j][0] = *(const bf16x8*)(row + lane * 8); v[j][1] = *(const bf16x8*)(row + 512 + lane * 8);
            if (lane < 32) { ra[j] = row[4096 + lane]; rb[j] = row[4096 + 32 + lane]; c2[j] = cs64[(size_t)tok * 32 + lane]; } } }
#pragma unroll
        for (int j = 0; j < 2; ++j) { const int tok = t0 + j * nw; if (tok < NTOK) { bf16_t* row = Ub + (size_t)tok * 4352;
#pragma unroll
            for (int w = 0; w < 2; ++w) { float a[8]; float ss = 0.f;
#pragma unroll
                for (int e = 0; e < 8; ++e) { a[e] = bf2f(v[j][w][e]); ss += a[e] * a[e]; }
#pragma unroll
                for (int o = 32; o >= 1; o >>= 1) ss += __shfl_xor(ss, o);
                const float rstd = rsqrtf(ss * (1.0f / 512.0f) + 1e-6f);
#pragma unroll
                for (int e = 0; e < 8; ++e) a[e] *= rstd;
                *(bf16x8*)((w ? CKVb : CQb) + (size_t)tok * 512 + lane * 8) = pack8(a); }
            if (lane < 32) { const float x1 = bfu2f(ra[j]), x2 = bfu2f(rb[j]); row[4096 + lane] = f2bf(x1 * c2[j].x - x2 * c2[j].y); row[4096 + 32 + lane] = f2bf(x2 * c2[j].x + x1 * c2[j].y); } } }
    }
}


__device__ __forceinline__ void krope_gemm(LAS unsigned char* L, const bf16_t* __restrict__ Hb, const bf16_t* __restrict__ Wt, const float* __restrict__ ssq, bf16_t* __restrict__ Ub) {
    const int tid = otid(), wid = tid >> 6, lane = tid & 63, r32 = lane & 31, hi = lane >> 5;
    LAS float* red = (LAS float*)L;
    for (int rt = blockIdx.x; rt < NTOK / 32; rt += gridDim.x) {
        const int row0 = rt * 32, k0 = wid * 256;
        const bf16_t* ap = Hb + (size_t)(row0 + r32) * DM + k0 + 8 * hi;
        const bf16_t* bp0 = Wt + (size_t)r32 * DM + k0 + 8 * hi; const bf16_t* bp1 = bp0 + (size_t)32 * DM;
        f32x16 c0 = {}, c1 = {};
        bf16x8 fa[3], fb0[3], fb1[3];
#pragma unroll
        for (int ks = 0; ks < 2; ++ks) { fa[ks] = *(const bf16x8*)(ap + 16 * ks); fb0[ks] = *(const bf16x8*)(bp0 + 16 * ks); fb1[ks] = *(const bf16x8*)(bp1 + 16 * ks); }
#pragma unroll
        for (int ks = 0; ks < 16; ++ks) {
            if (ks + 2 < 16) { fa[(ks + 2) % 3] = *(const bf16x8*)(ap + 16 * (ks + 2)); fb0[(ks + 2) % 3] = *(const bf16x8*)(bp0 + 16 * (ks + 2)); fb1[(ks + 2) % 3] = *(const bf16x8*)(bp1 + 16 * (ks + 2)); }
            c0 = __builtin_amdgcn_mfma_f32_32x32x16_bf16(fa[ks % 3], fb0[ks % 3], c0, 0, 0, 0); c1 = __builtin_amdgcn_mfma_f32_32x32x16_bf16(fa[ks % 3], fb1[ks % 3], c1, 0, 0, 0); }
#pragma unroll
        for (int i = 0; i < 16; ++i) { red[((wid * 2 + 0) * 16 + i) * 64 + lane] = c0[i]; red[((wid * 2 + 1) * 16 + i) * 64 + lane] = c1[i]; }
        __syncthreads();
#pragma unroll
        for (int q = 0; q < 4; ++q) { const int idx = tid + 512 * q, blk = idx >> 10, i = (idx >> 6) & 15, ln = idx & 63;
            float sum = 0.f;
#pragma unroll
            for (int w = 0; w < 8; ++w) sum += red[((w * 2 + blk) * 16 + i) * 64 + ln];
            const int row = row0 + (i & 3) + 8 * (i >> 2) + 4 * (ln >> 5), col = 32 * blk + (ln & 31);
            const float rs = rsqrtf(ssq[row] * (1.0f / DM) + 1e-6f);
            Ub[(size_t)row * 4352 + 4096 + col] = f2bf(sum * rs); }
        __syncthreads();
    }
}

__device__ __forceinline__ unsigned f2ord(float f) { const unsigned b = __float_as_uint(f); return (b & 0x80000000u) ? ~b : (b | 0x80000000u); }
__device__ __forceinline__ void phase_indexer(const bf16_t* __restrict__ U, const float2* __restrict__ cs64, unsigned* __restrict__ MASK) {
    constexpr int LDU = 6656;
    const int tid_ = otid(), lane = tid_ & 63, gw = blockIdx.x * 8 + (tid_ >> 6), nw = gridDim.x * 8;
    const int m = lane & 31, kh = lane >> 5, aq = (m >> 2) & 1, ah = ((m >> 3) << 2) | (m & 3);
    for (int task0 = gw; task0 < 2048; task0 += nw)
        for (int half = 0; half < 2; ++half) {
            const int task = half ? 4095 - task0 : task0;
            const int b = task >> 10, p = task & 1023, tokA = b * SEQ + 2 * p;
            bf16x8 a[4];
            { const bf16_t* src = U + (size_t)(tokA + aq) * LDU + 2304 + ah * 64 + kh * 8;
#pragma unroll
              for (int kk = 0; kk < 4; ++kk) a[kk] = *(const bf16x8*)(src + 16 * kk);
              const float2* cs = cs64 + (size_t)(tokA + aq) * 32 + kh * 8;
#pragma unroll
              for (int kk = 0; kk < 2; ++kk) { float y1[8], y2[8];
#pragma unroll
                  for (int e = 0; e < 8; ++e) { const float2 c = cs[16 * kk + e]; const float x1 = bf2f(a[kk][e]), x2 = bf2f(a[kk + 2][e]); y1[e] = x1 * c.x - x2 * c.y; y2[e] = x2 * c.x + x1 * c.y; }
                  a[kk] = pack8(y1); a[kk + 2] = pack8(y2); } }
            float wl[16];
            { const bf16_t* wp = U + (size_t)(tokA + kh) * LDU + 6528; const bf16x8 w0 = *(const bf16x8*)wp, w1 = *(const bf16x8*)(wp + 8);
#pragma unroll
              for (int e = 0; e < 8; ++e) { wl[e] = bf2f(w0[e]); wl[8 + e] = bf2f(w1[e]); } }
            const int qpos = 2 * p + kh, tmax = (2 * p + 1) >> 5;
            const bf16_t* kb = U + (size_t)(b * SEQ + m) * LDU + 6400 + kh * 8;
            unsigned sc[64];
            bf16x8 bn[4];
#pragma unroll
            for (int kk = 0; kk < 4; ++kk) bn[kk] = *(const bf16x8*)(kb + 16 * kk);
#pragma unroll
            for (int t = 0; t < 64; ++t) {
                if (t <= tmax) {
                    bf16x8 bc[4];
#pragma unroll
                    for (int kk = 0; kk < 4; ++kk) bc[kk] = bn[kk];
                    if (t + 1 <= tmax) {
#pragma unroll
                        for (int kk = 0; kk < 4; ++kk) bn[kk] = *(const bf16x8*)(kb + (size_t)(32 * (t + 1)) * LDU + 16 * kk); }
                    f32x16 acc = {};
#pragma unroll
                    for (int kk = 0; kk < 4; ++kk) acc = __builtin_amdgcn_mfma_f32_32x32x16_bf16(a[kk], bc[kk], acc, 0, 0, 0);
                    float s = 0.f;
#pragma unroll
                    for (int i = 0; i < 16; ++i) s = fmaf(wl[i], fmaxf(acc[i], 0.f), s);
                    sc[t] = (32 * t + m <= qpos) ? f2ord(s) : 0u;
                } else sc[t] = 0u;
            }
            unsigned T = 0u;
            bool done = (qpos < 256);
            for (int bit = 31; bit >= 0; --bit) {
                if (__all(done)) break;
                const unsigned cand = T | (1u << bit);
                int cnt = 0;
#pragma unroll
                for (int t = 0; t < 64; ++t) cnt += (sc[t] >= cand) ? 1 : 0;
                cnt += __shfl_xor(cnt, 16); cnt += __shfl_xor(cnt, 8); cnt += __shfl_xor(cnt, 4); cnt += __shfl_xor(cnt, 2); cnt += __shfl_xor(cnt, 1);
                if (!done && cnt >= 256) { T = cand; done = (cnt == 256); }
            }
            const unsigned thr = T < 1u ? 1u : T;
            unsigned mwA = 0u, mwB = 0u;
#pragma unroll
            for (int t = 0; t < 64; ++t) { const unsigned long long bal = __ballot(sc[t] >= thr);
                if (lane == t) { mwA = (unsigned)bal; mwB = (unsigned)(bal >> 32); } }
            MASK[(size_t)tokA * 64 + lane] = mwA; MASK[(size_t)(tokA + 1) * 64 + lane] = mwB;
        }
}

#define KSWZ(row, colB) ((row) * 256 + ((colB) ^ (((row) & 7) << 4)))
#define KRSWZ(row, colB) ((row) * 128 + ((colB) ^ ((((row) >> 1) & 7) << 4)))
constexpr int A_V = 0, A_K = 65536, A_KR = 114688, A_WS = 139264, A_CB = 141312, A_SC = 149504;
__device__ __forceinline__ int crow(int r, int hi) { return (r & 3) + 8 * (r >> 2) + 4 * hi; }
__device__ __forceinline__ int v_st(int k, int c) { const int kk = (k & ~0xC) | ((k & 4) << 1) | ((k & 8) >> 1); return ((kk >> 3) * 4 + (c >> 5)) * 512 + ((kk & 7) * 32 + (c & 31)) * 2; }
__device__ __forceinline__ int v_rd_base(int lane) { return ((lane & 3) << 3) | (((lane >> 2) & 3) << 6) | (((lane >> 4) & 1) << 5) | (((lane >> 5) & 1) << 8); }
constexpr int v_rd_off(int d0, int ks, int half) { return d0 * 512 + ks * 4096 + half * 2048; }
template <int OFF> __device__ __forceinline__ s16x4 tr_read(int vb) {
    s16x4 r; asm volatile("ds_read_b64_tr_b16 %0, %1 offset:%2" : "=&v"(r) : "v"(vb), "i"(OFF) : "memory"); return r;
}
template <int D0> __device__ __forceinline__ void pv_two(f32x16& oa, f32x16& ob, int vb, bf16x8 pa0, bf16x8 pa1, bf16x8 pa2, bf16x8 pa3) {
    const s16x4 l0 = tr_read<v_rd_off(D0, 0, 0)>(vb), h0 = tr_read<v_rd_off(D0, 0, 1)>(vb), l1 = tr_read<v_rd_off(D0, 1, 0)>(vb), h1 = tr_read<v_rd_off(D0, 1, 1)>(vb);
    const s16x4 l2 = tr_read<v_rd_off(D0, 2, 0)>(vb), h2 = tr_read<v_rd_off(D0, 2, 1)>(vb), l3 = tr_read<v_rd_off(D0, 3, 0)>(vb), h3 = tr_read<v_rd_off(D0, 3, 1)>(vb);
    const s16x4 m0 = tr_read<v_rd_off(D0 + 1, 0, 0)>(vb), n0 = tr_read<v_rd_off(D0 + 1, 0, 1)>(vb), m1 = tr_read<v_rd_off(D0 + 1, 1, 0)>(vb), n1 = tr_read<v_rd_off(D0 + 1, 1, 1)>(vb);
    const s16x4 m2 = tr_read<v_rd_off(D0 + 1, 2, 0)>(vb), n2 = tr_read<v_rd_off(D0 + 1, 2, 1)>(vb), m3 = tr_read<v_rd_off(D0 + 1, 3, 0)>(vb), n3 = tr_read<v_rd_off(D0 + 1, 3, 1)>(vb);
    asm volatile("s_waitcnt lgkmcnt(0)" ::: "memory"); __builtin_amdgcn_sched_barrier(0);
#define PK(L, H) (bf16x8){L[0], L[1], L[2], L[3], H[0], H[1], H[2], H[3]}
    oa = __builtin_amdgcn_mfma_f32_32x32x16_bf16(pa0, PK(l0, h0), oa, 0, 0, 0);
    ob = __builtin_amdgcn_mfma_f32_32x32x16_bf16(pa0, PK(m0, n0), ob, 0, 0, 0);
    oa = __builtin_amdgcn_mfma_f32_32x32x16_bf16(pa1, PK(l1, h1), oa, 0, 0, 0);
    ob = __builtin_amdgcn_mfma_f32_32x32x16_bf16(pa1, PK(m1, n1), ob, 0, 0, 0);
    oa = __builtin_amdgcn_mfma_f32_32x32x16_bf16(pa2, PK(l2, h2), oa, 0, 0, 0);
    ob = __builtin_amdgcn_mfma_f32_32x32x16_bf16(pa2, PK(m2, n2), ob, 0, 0, 0);
    oa = __builtin_amdgcn_mfma_f32_32x32x16_bf16(pa3, PK(l3, h3), oa, 0, 0, 0);
    ob = __builtin_amdgcn_mfma_f32_32x32x16_bf16(pa3, PK(m3, n3), ob, 0, 0, 0);
#undef PK
}

enum { K_FOX = 0, K_DSA = 1, K_DIL = 2, K_MLA = 3, K_MEM = 4 };

template <int KIND>
__device__ __forceinline__ void load_q(bf16x8 (&qr)[12], const bf16_t* __restrict__ qp, const float2* __restrict__ c128, const float2* __restrict__ c64, int hi, float C) {
#pragma unroll
    for (int d0 = 0; d0 < 8; ++d0) qr[d0] = *(const bf16x8*)(qp + hi * 8 + d0 * 16);
#pragma unroll
    for (int d0 = 0; d0 < 4; ++d0) qr[8 + d0] = (KIND == K_MLA) ? *(const bf16x8*)(qp + 128 + hi * 8 + d0 * 16) : (bf16x8){0, 0, 0, 0, 0, 0, 0, 0};
    if (KIND == K_DSA || KIND == K_DIL) {
#pragma unroll
        for (int d0 = 0; d0 < 4; ++d0) { const float2* cs = c128 + 16 * d0 + 8 * hi; float y1[8], y2[8];
#pragma unroll
            for (int e = 0; e < 8; ++e) { const float2 c = cs[e]; const float x1 = bf2f(qr[d0][e]), x2 = bf2f(qr[d0 + 4][e]); y1[e] = (x1 * c.x - x2 * c.y) * C; y2[e] = (x2 * c.x + x1 * c.y) * C; }
            qr[d0] = pack8(y1); qr[d0 + 4] = pack8(y2); }
    } else {
#pragma unroll
        for (int d0 = 0; d0 < 8; ++d0) { float y[8];
#pragma unroll
            for (int e = 0; e < 8; ++e) y[e] = bf2f(qr[d0][e]) * C;
            qr[d0] = pack8(y); }
    }
    if (KIND == K_MLA) {
#pragma unroll
        for (int d0 = 0; d0 < 2; ++d0) { const float2* cs = c64 + 16 * d0 + 8 * hi; float y1[8], y2[8];
#pragma unroll
            for (int e = 0; e < 8; ++e) { const float2 c = cs[e]; const float x1 = bf2f(qr[8 + d0][e]), x2 = bf2f(qr[10 + d0][e]); y1[e] = (x1 * c.x - x2 * c.y) * C; y2[e] = (x2 * c.x + x1 * c.y) * C; }
            qr[8 + d0] = pack8(y1); qr[10 + d0] = pack8(y2); }
    }
}

__device__ __forceinline__ void attn_finish(f32x16 (&o)[4], float& m_reg, float& l_reg, f32x16& p0, f32x16& p1, int vb, LAS float* al_l, int r32, int hi) {
            float pmax = p0[0];
#pragma unroll
            for (int r = 1; r < 16; ++r) pmax = fmaxf(pmax, p0[r]);
#pragma unroll
            for (int r = 0; r < 16; ++r) pmax = fmaxf(pmax, p1[r]);
            { auto rr = __builtin_amdgcn_permlane32_swap(__float_as_uint(pmax), __float_as_uint(pmax), false, false);
              pmax = fmaxf(__uint_as_float(rr[0]), __uint_as_float(rr[1])); }
            float mn = m_reg, alpha = 1.f;
            const bool resc = !__all(pmax - m_reg <= 10.0f);
            if (resc) { mn = fmaxf(m_reg, pmax); alpha = __builtin_amdgcn_exp2f(m_reg - mn); m_reg = mn; }
            float ps = 0.f;
#pragma unroll
            for (int r = 0; r < 16; ++r) { p0[r] = __builtin_amdgcn_exp2f(p0[r] - mn); p1[r] = __builtin_amdgcn_exp2f(p1[r] - mn); }
#pragma unroll
            for (int r = 0; r < 16; ++r) ps += p0[r] + p1[r];
            { auto rr = __builtin_amdgcn_permlane32_swap(__float_as_uint(ps), __float_as_uint(ps), false, false);
              ps = __uint_as_float(rr[0]) + __uint_as_float(rr[1]); }
            l_reg = l_reg * alpha + ps;
            bf16x8 pa0, pa1, pa2, pa3;
#define PK4(P, BASE, OUT) do { unsigned a0 = cvtpk(P[BASE + 0], P[BASE + 1]), a1 = cvtpk(P[BASE + 2], P[BASE + 3]);   \
    unsigned b0 = cvtpk(P[BASE + 4], P[BASE + 5]), b1 = cvtpk(P[BASE + 6], P[BASE + 7]);                              \
    auto r0 = __builtin_amdgcn_permlane32_swap(a0, b0, false, false); auto r1 = __builtin_amdgcn_permlane32_swap(a1, b1, false, false); \
    u32x4 w = {r0[0], r1[0], r0[1], r1[1]}; OUT = __builtin_bit_cast(bf16x8, w); } while (0)
            PK4(p0, 0, pa0); PK4(p0, 8, pa1); PK4(p1, 0, pa2); PK4(p1, 8, pa3);
#undef PK4
            if (resc) { if (hi == 0) al_l[r32] = alpha; asm volatile("s_waitcnt lgkmcnt(0)" ::: "memory");
#pragma unroll
                for (int r = 0; r < 16; ++r) { const float al = al_l[crow(r, hi)];
#pragma unroll
                    for (int d = 0; d < 4; ++d) o[d][r] *= al; } }
            pv_two<0>(o[0], o[1], vb, pa0, pa1, pa2, pa3); pv_two<2>(o[2], o[3], vb, pa0, pa1, pa2, pa3);
}

template <int KIND>
__device__ __forceinline__ void attn_segment(LAS unsigned char* L, f32x16 (&o)[4], float& m_reg, float& l_reg, const bf16x8 (&qr)[12],
        const bf16_t* __restrict__ Kp, const bf16_t* __restrict__ Vp, int ldk, int ldv, const bf16_t* __restrict__ KRp, int ldkr,
        int kt0, int kts, int j0, int j1, int tq, int tq_lo, int tq_hi, int wtok, int dmask, float C, const unsigned* __restrict__ maskrow) {
    const int tid = otid(), wid = tid >> 6, lane = tid & 63, r32 = lane & 31, hi = lane >> 5;
    LAS float* al_l = (LAS float*)(L + A_WS) + wid * 64 + 32;
    const int vbase = (int)(unsigned)(uintptr_t)(L + A_V) + v_rd_base(lane);
    int kx[4], krx[4];
#pragma unroll
    for (int q = 0; q < 4; ++q) { kx[q] = KSWZ(r32, (q * 16 + hi * 8) * 2); krx[q] = KRSWZ(r32, (q * 16 + hi * 8) * 2); }
    const int wu = __builtin_amdgcn_readfirstlane(wid);
    unsigned ksrc[2], vsrc[2], krsrc = 0u;
#pragma unroll
    for (int q = 0; q < 2; ++q) {
        const int krow = 4 * (2 * wu + q) + (lane >> 4), kcol = 8 * ((lane & 15) ^ (krow & 7));
        ksrc[q] = (unsigned)(kt0 + krow * kts) * (unsigned)ldk + (unsigned)kcol;
        const int kk = 8 * wu + ((lane & 31) >> 2), vk = (kk & ~0xC) | ((kk & 4) << 1) | ((kk & 8) >> 1), vc = 32 * ((2 * q + (lane >> 5)) & 3) + 8 * (lane & 3);
        vsrc[q] = (unsigned)(kt0 + vk * kts) * (unsigned)ldv + (unsigned)vc;
    }
    if (KIND == K_MLA) { const int rrow = 8 * wu + (lane >> 3), rcol = 8 * ((lane & 7) ^ ((rrow >> 1) & 7)); krsrc = (unsigned)(kt0 + rrow * kts) * (unsigned)ldkr + (unsigned)rcol; }
    const unsigned kstep = 64u * (unsigned)kts * (unsigned)ldk, vstep = 64u * (unsigned)kts * (unsigned)ldv, krstep = 64u * (unsigned)kts * (unsigned)ldkr;
    uint2 mw = make_uint2(0u, 0u), mwn = make_uint2(0u, 0u);
#define DMA16(gp, lp) __builtin_amdgcn_global_load_lds((const unsigned*)(gp), (LAS unsigned*)(lp), 16, 0, 0)
#define STAGE(j, kslot, vslot) do { _Pragma("unroll") for (int _q = 0; _q < 2; ++_q) { \
            DMA16(Kp + (ksrc[_q] + (unsigned)(j) * kstep), L + A_K + (kslot) * 16384 + (2 * wu + _q) * 1024); \
            DMA16(Vp + (vsrc[_q] + (unsigned)(j) * vstep), L + A_V + (vslot) * 16384 + (2 * wu + _q) * 1024); } \
        if (KIND == K_MLA) DMA16(KRp + (krsrc + (unsigned)(j) * krstep), L + A_KR + (kslot) * 8192 + wu * 1024); } while (0)
#define WAIT_TILE() do { if (KIND == K_MLA) asm volatile("s_waitcnt vmcnt(5)" ::: "memory"); else asm volatile("s_waitcnt vmcnt(4)" ::: "memory"); } while (0)
    const bool grpB = (wu >= 4);
    int kc = 0, vc = 0;
    if (KIND == K_DSA) mw = *(const uint2*)(maskrow + 2 * j0);
    STAGE(j0, 0, 0);
    if (j0 + 1 < j1) { if (KIND == K_DSA) mwn = *(const uint2*)(maskrow + 2 * (j0 + 1)); STAGE(j0 + 1, 1, 1); WAIT_TILE(); }
    else asm volatile("s_waitcnt vmcnt(0)" ::: "memory");
    __syncthreads();
    f32x16 p0 = {}, p1 = {};
    bool pvalid = false;
    for (int j = j0; j <= j1; ++j) {
        const bool st2 = (j + 2 < j1);
        uint2 mwnn = make_uint2(0u, 0u);
        if (st2) { if (KIND == K_DSA) mwnn = *(const uint2*)(maskrow + 2 * (j + 2)); STAGE(j + 2, (kc + 2) % 3, (vc + 2) & 3); }
        if (grpB && pvalid) attn_finish(o, m_reg, l_reg, p0, p1, vbase + ((vc + 3) & 3) * 16384, al_l, r32, hi);
        pvalid = false;
        if (j < j1) {
            const int tkmin = kt0 + 64 * j * kts, tkmax = tkmin + 63 * kts;
            const bool need = (KIND == K_MEM) || (tkmin <= tq_hi && tkmax >= tq_lo - wtok);
            if (need) {
                pvalid = true;
                if (KIND == K_FOX) {
#pragma unroll
                    for (int g = 0; g < 4; ++g) { const f32x4 c0 = *(const LAS f32x4*)(L + A_CB + (64 * j + 4 * hi + 8 * g) * 4), c1 = *(const LAS f32x4*)(L + A_CB + (64 * j + 32 + 4 * hi + 8 * g) * 4);
#pragma unroll
                        for (int e = 0; e < 4; ++e) { p0[4 * g + e] = c0[e]; p1[4 * g + e] = c1[e]; } }
                } else {
#pragma unroll
                    for (int r = 0; r < 16; ++r) { p0[r] = 0.f; p1[r] = 0.f; }
                }
            { LAS unsigned char* Kb = L + A_K + kc * 16384;
#pragma unroll
              for (int d0 = 0; d0 < 8; ++d0) { LAS unsigned char* ka = Kb + kx[d0 & 3] + (d0 >> 2) * 128;
                  const bf16x8 b0 = *(const LAS bf16x8*)(ka), b1 = *(const LAS bf16x8*)(ka + 8192);
                  p0 = __builtin_amdgcn_mfma_f32_32x32x16_bf16(b0, qr[d0], p0, 0, 0, 0);
                  p1 = __builtin_amdgcn_mfma_f32_32x32x16_bf16(b1, qr[d0], p1, 0, 0, 0);
                  if (KIND == K_MLA && (d0 & 3) == 3) __builtin_amdgcn_sched_barrier(0); } }
            if (KIND == K_MLA) { LAS unsigned char* Kr = L + A_KR + kc * 8192;
#pragma unroll
              for (int d0 = 0; d0 < 4; ++d0) { LAS unsigned char* ka = Kr + krx[d0];
                  const bf16x8 b0 = *(const LAS bf16x8*)(ka), b1 = *(const LAS bf16x8*)(ka + 4096);
                  p0 = __builtin_amdgcn_mfma_f32_32x32x16_bf16(b0, qr[8 + d0], p0, 0, 0, 0);
                  p1 = __builtin_amdgcn_mfma_f32_32x32x16_bf16(b1, qr[8 + d0], p1, 0, 0, 0);
                  __builtin_amdgcn_sched_barrier(0); } }
            if (KIND == K_DSA) { const int sh0 = (int)(mw.x >> (4 * hi)), sh1 = (int)(mw.y >> (4 * hi));
#pragma unroll
                for (int r = 0; r < 16; ++r) { const int cr = (r & 3) + 8 * (r >> 2);
                    const unsigned t0 = (unsigned)__builtin_amdgcn_sbfe(sh0, cr, 1), t1 = (unsigned)__builtin_amdgcn_sbfe(sh1, cr, 1);
                    p0[r] = __uint_as_float((__float_as_uint(p0[r]) & t0) | (0xFF800000u & ~t0)); p1[r] = __uint_as_float((__float_as_uint(p1[r]) & t1) | (0xFF800000u & ~t1)); }
            } else if (KIND != K_MEM) {
                const bool allvalid = (dmask == 0) && (tkmax <= tq_lo) && (tkmin >= tq_hi - wtok);
                if (!allvalid) { const int dbase = tq - kt0 - kts * (64 * j + 4 * hi);
#pragma unroll
                    for (int r = 0; r < 16; ++r) { const int cr = (r & 3) + 8 * (r >> 2); const int d = dbase - kts * cr, d1 = d - 32 * kts;
                        const bool v0 = ((unsigned)d <= (unsigned)wtok) && ((d & dmask) == 0), v1 = ((unsigned)d1 <= (unsigned)wtok) && ((d1 & dmask) == 0);
                        p0[r] = v0 ? p0[r] : -INFINITY; p1[r] = v1 ? p1[r] : -INFINITY; } }
            }
            }
        }
        if (!grpB && pvalid) { attn_finish(o, m_reg, l_reg, p0, p1, vbase + vc * 16384, al_l, r32, hi); pvalid = false; }
        if (KIND == K_DSA) { mw = mwn; mwn = mwnn; }
        if (st2) WAIT_TILE(); else asm volatile("s_waitcnt vmcnt(0)" ::: "memory");
        __syncthreads();
        kc = (kc == 2) ? 0 : kc + 1; vc = (vc + 1) & 3;
    }
#undef STAGE
#undef WAIT_TILE
#undef DMA16
}

__device__ __forceinline__ void attn_epilogue(LAS unsigned char* L, const f32x16 (&o)[4], float l_reg, int tok0, int tstride,
        const bf16_t* __restrict__ Z, int ldz, bf16_t* __restrict__ Gd, int ldg) {
    const int tid = otid(), wid = tid >> 6, lane = tid & 63, r32 = lane & 31, hi = lane >> 5;
    LAS float* li_l = (LAS float*)(L + A_WS) + wid * 64;
    if (hi == 0) li_l[r32] = l_reg;
    asm volatile("s_waitcnt lgkmcnt(0)" ::: "memory");
#pragma unroll
    for (int rb = 0; rb < 2; ++rb) {
        bf16_t zv[8][4]; float rl[8]; unsigned toff[8];
#pragma unroll
        for (int rr = 0; rr < 8; ++rr) { const int r = 8 * rb + rr, row = crow(r, hi);
            const unsigned tok = (unsigned)(tok0 + (32 * wid + row) * tstride); toff[rr] = tok;
            const bf16_t* zp = Z + tok * (unsigned)ldz + r32;
#pragma unroll
            for (int d0 = 0; d0 < 4; ++d0) zv[rr][d0] = zp[32 * d0];
            rl[rr] = __builtin_amdgcn_rcpf(li_l[row]); }
#pragma unroll
        for (int rr = 0; rr < 8; ++rr) { const int r = 8 * rb + rr;
            bf16_t* gp = Gd + toff[rr] * (unsigned)ldg + r32;
#pragma unroll
            for (int d0 = 0; d0 < 4; ++d0) { const float y = o[d0][r] * rl[rr]; const float z = bfu2f(zv[rr][d0]);
                gp[32 * d0] = f2bf(y * z * __builtin_amdgcn_rcpf(1.0f + __expf(-z))); } }
    }
}

__device__ __forceinline__ void mem_items(LAS unsigned char* L, int it0, int itstep, const bf16_t* __restrict__ U, int ldu, int qcol, int zcol, const bf16_t* __restrict__ MKV, int layer, bf16_t* __restrict__ Gd, int ldg, int gcol) {
    const int tid = otid(), wid = tid >> 6, lane = tid & 63, r32 = lane & 31, hi = lane >> 5;
    for (int it = it0; it < 128; it += itstep) {
        const int qb = it & 7, mh = (it >> 3) & 3, b = it >> 5;
        const int tok0 = b * SEQ + qb * 256, tq = qb * 256 + 32 * wid + r32;
        bf16x8 qr[12];
        load_q<K_MEM>(qr, U + (size_t)(tok0 + 32 * wid + r32) * ldu + qcol + mh * 128, nullptr, nullptr, hi, 0.088388347648318440f * LOG2E);
        f32x16 o[4] = {}; float m_reg = -1e30f, l_reg = 0.f;
        const bf16_t* Kp = MKV + (size_t)(b * 256) * 4096 + layer * 1024 + mh * 128;
        attn_segment<K_MEM>(L, o, m_reg, l_reg, qr, Kp, Kp + 512, 4096, 4096, nullptr, 0, 0, 1, 0, 4, tq, 0, 0, 0, 0, 0.088388347648318440f * LOG2E, nullptr);
        attn_epilogue(L, o, l_reg, tok0, 1, U + zcol + mh * 128, ldu, Gd + gcol + mh * 128, ldg);
    }
}

template <int KIND>
__device__ __forceinline__ void causal_items(LAS unsigned char* L, int it0, const Params& p, const bf16_t* __restrict__ U, int ldu, bf16_t* __restrict__ Gd) {
    const int tid = otid(), wid = tid >> 6, lane = tid & 63, r32 = lane & 31, hi = lane >> 5;
    const float2* cs128 = (const float2*)(p.ws + WS_CS128); const float2* cs64 = (const float2*)(p.ws + WS_CS64);
    for (int it = it0; it < 256; it += gridDim.x) {
        const int x = it & 3, h = (it >> 2) & 15, b = it >> 6;
        if (KIND == K_FOX) {
            float lf[4]; const float fb = p.in[5][h];
#pragma unroll
            for (int e = 0; e < 4; ++e) { const float xx = bfu2f(U[(size_t)(b * SEQ + 4 * tid + e) * ldu + 9216 + h]) + fb;
                lf[e] = (xx >= 0.f) ? -log1pf(expf(-xx)) : xx - log1pf(expf(xx)); }
            const float s1 = lf[0], s2 = s1 + lf[1], s3 = s2 + lf[2], s4 = s3 + lf[3];
            float inc = s4;
#pragma unroll
            for (int d = 1; d < 64; d <<= 1) { const float t = __shfl_up(inc, d); if (lane >= d) inc += t; }
            LAS float* wsum = (LAS float*)(L + A_SC);
            if (lane == 63) wsum[wid] = inc;
            __syncthreads();
            float off = 0.f;
            for (int w = 0; w < wid; ++w) off += wsum[w];
            const float ex = off + inc - s4;
            f32x4 cb = {-(ex + s1) * LOG2E, -(ex + s2) * LOG2E, -(ex + s3) * LOG2E, -(ex + s4) * LOG2E};
            *(LAS f32x4*)(L + A_CB + tid * 16) = cb;
            __syncthreads();
        }
        for (int sub = 0; sub < 2; ++sub) {
            const int qb = sub ? x : 7 - x;
            const int tok0 = b * SEQ + qb * 256, tql = qb * 256 + 32 * wid, tq = tql + r32, mytok = tok0 + 32 * wid + r32;
            bf16x8 qr[12];
            f32x16 o[4] = {}; float m_reg = -1e30f, l_reg = 0.f;
            if (KIND == K_FOX) {
                load_q<K_FOX>(qr, U + (size_t)mytok * ldu + h * 128, nullptr, nullptr, hi, 0.088388347648318440f * LOG2E);
                const bf16_t* Kp = U + (size_t)(b * SEQ) * ldu + 2048 + h * 128;
                attn_segment<K_FOX>(L, o, m_reg, l_reg, qr, Kp, Kp + 2048, ldu, ldu, nullptr, 0, 0, 1, 0, 4 * (qb + 1), tq, tql, tql + 31, 0x7fffffff, 0, 0.088388347648318440f * LOG2E, nullptr);
                attn_epilogue(L, o, l_reg, tok0, 1, U + 6656 + h * 128, ldu, Gd + h * 128, 2560);
            } else if (KIND == K_DSA) {
                load_q<K_DSA>(qr, U + (size_t)mytok * ldu + h * 128, cs128 + (size_t)mytok * 64, nullptr, hi, 0.088388347648318440f * LOG2E);
                const bf16_t* Kp = U + (size_t)(b * SEQ) * ldu + 2048;
                attn_segment<K_DSA>(L, o, m_reg, l_reg, qr, Kp, Kp + 128, ldu, ldu, nullptr, 0, 0, 1, 0, 4 * (qb + 1), tq, tql, tql + 31, 0x7fffffff, 0, 0.088388347648318440f * LOG2E,
                                    (const unsigned*)(p.ws + WS_MASK) + (size_t)mytok * 64);
                attn_epilogue(L, o, l_reg, tok0, 1, U + 3840 + h * 128, ldu, Gd + h * 128, 2560);
            } else {
                const bf16_t* Q3 = (const bf16_t*)(p.ws + WS_Q3); const bf16_t* KV3 = (const bf16_t*)(p.ws + WS_KV3);
                load_q<K_MLA>(qr, Q3 + (size_t)mytok * 3072 + h * 192, nullptr, cs64 + (size_t)mytok * 32, hi, 0.072168783648703220f * LOG2E);
                const bf16_t* Kp = KV3 + (size_t)(b * SEQ) * 4096 + h * 256;
                attn_segment<K_MLA>(L, o, m_reg, l_reg, qr, Kp, Kp + 128, 4096, 4096, U + (size_t)(b * SEQ) * ldu + 4096, ldu, 0, 1, 0, 4 * (qb + 1), tq, tql, tql + 31, 0x7fffffff, 0,
                                    0.072168783648703220f * LOG2E, nullptr);
                attn_epilogue(L, o, l_reg, tok0, 1, U + 1536 + h * 128, ldu, Gd + h * 128, 2560);
            }
        }
    }
}

__device__ __forceinline__ void dilA_items(LAS unsigned char* L, int it0, const Params& p, const bf16_t* __restrict__ U, float* __restrict__ SO, float* __restrict__ SML) {
    constexpr int ldu = 8704;
    const int tid = otid(), wid = tid >> 6, lane = tid & 63, r32 = lane & 31, hi = lane >> 5;
    const float2* cs128 = (const float2*)(p.ws + WS_CS128);
    for (int it = it0; it < 192; it += gridDim.x) {
        const int qb = it & 7, gq = it >> 3, hg = gq % 6, b = gq / 6;
        const int tok0 = b * SEQ + qb * 256, tql = qb * 256 + 32 * wid, tq = tql + r32, mytok = tok0 + 32 * wid + r32;
        f32x16 o[4] = {}; float m_reg = -1e30f, l_reg = 0.f;
        bf16x8 qr[12];
        load_q<K_DIL>(qr, U + (size_t)mytok * ldu + hg * 128, cs128 + (size_t)mytok * 64, nullptr, hi, 0.088388347648318440f * LOG2E);
        const bf16_t* Kp = U + (size_t)(b * SEQ) * ldu + 2304 + hg * 128;
        attn_segment<K_DIL>(L, o, m_reg, l_reg, qr, Kp, Kp + 2304, ldu, ldu, nullptr, 0, 0, 1, qb ? 4 * qb - 2 : 0, 4 * (qb + 1), tq, tql, tql + 31, 128, 0, 0.088388347648318440f * LOG2E, nullptr);
        float* so = SO + ((size_t)tok0 * 6 + hg) * 128;
#pragma unroll
        for (int r = 0; r < 16; ++r) { const unsigned off = (unsigned)((32 * wid + crow(r, hi)) * 768 + r32);
#pragma unroll
            for (int d0 = 0; d0 < 4; ++d0) so[off + 32u * d0] = o[d0][r]; }
        if (hi == 0) { float* ml = SML + ((size_t)mytok * 6 + hg) * 2; ml[0] = m_reg; ml[1] = l_reg; }
    }
}
__device__ __forceinline__ void dil_items(LAS unsigned char* L, int it0, const Params& p, const bf16_t* __restrict__ U, bf16_t* __restrict__ Gd, const float* __restrict__ SO, const float* __restrict__ SML) {
    constexpr int g_begin = 1;
    constexpr int ldu = 8704;
    const int tid = otid(), wid = tid >> 6, lane = tid & 63, r32 = lane & 31, hi = lane >> 5;
    const float2* cs128 = (const float2*)(p.ws + WS_CS128);
    for (int it = it0; it < 192; it += gridDim.x) {
        const int rr = it & 7, gq = it >> 3, hg = gq % 6, b = gq / 6;
        const int i = 32 * wid + r32, tq = rr + 8 * i, tql = rr + 8 * 32 * wid, tqh = tql + 8 * 31, mytok = b * SEQ + tq;
        f32x16 o[4] = {}; float m_reg = -1e30f, l_reg = 0.f;
        if (g_begin) {
            const float* so = SO + ((size_t)(b * SEQ + rr) * 6 + hg) * 128;
#pragma unroll
            for (int r = 0; r < 16; ++r) { const unsigned off = (unsigned)(8 * (32 * wid + crow(r, hi)) * 768 + r32);
#pragma unroll
                for (int d0 = 0; d0 < 4; ++d0) o[d0][r] = so[off + 32u * d0]; }
            const float* ml = SML + ((size_t)mytok * 6 + hg) * 2; m_reg = ml[0]; l_reg = ml[1];
        }
        for (int g = g_begin; g < 3; ++g) {
            const int hd = g * 6 + hg;
            bf16x8 qr[12];
            const int t2 = otid(), mytok2 = b * SEQ + rr + 8 * (32 * (t2 >> 6) + (t2 & 31));
            load_q<K_DIL>(qr, U + (size_t)mytok2 * ldu + hd * 128, cs128 + (size_t)mytok2 * 64, nullptr, (t2 >> 5) & 1, 0.088388347648318440f * LOG2E);
            const bf16_t* Kp = U + (size_t)(b * SEQ) * ldu + 2304 + hd * 128;
            const int kts = (g == 1) ? 4 : 8, kt0 = (g == 1) ? (rr & 3) : rr;
            const int ntile = (g == 1) ? 8 : 4, wtok = (g == 1) ? 512 : 2048, dmask = (g == 2) ? 15 : 0;
            attn_segment<K_DIL>(L, o, m_reg, l_reg, qr, Kp, Kp + 2304, ldu, ldu, nullptr, 0, kt0, kts, 0, ntile, tq, tql, tqh, wtok, dmask, 0.088388347648318440f * LOG2E, nullptr);
        }
        attn_epilogue(L, o, l_reg, b * SEQ + rr, 8, U + 7424 + hg * 128, ldu, Gd + hg * 128, 1280);
    }
}


#define XB_TMO      128
#define XB_XCNT(j)  (256  + 64 * (j))
#define XB_XSUB(j)  (1280 + 64 * (j))
#define XB_XGEN(j)  (2304 + 64 * (j))
#define XB_TOP      3328
#define XB_TOPGEN   3392
#define XCD_BAR_WORDS 3456
#define XB_SPIN_CAP (1u << 18)
__device__ __forceinline__ unsigned xb_ld(unsigned* p)              { return __hip_atomic_load(p, __ATOMIC_RELAXED, __HIP_MEMORY_SCOPE_AGENT); }
__device__ __forceinline__ unsigned xb_add(unsigned* p, unsigned v) { return __hip_atomic_fetch_add(p, v, __ATOMIC_RELAXED, __HIP_MEMORY_SCOPE_AGENT); }
__device__ __forceinline__ unsigned xb_xcc_id() { return (unsigned)__builtin_amdgcn_s_getreg((3 << 11) | 20) & 0xFu; }
#define XB_SPIN(cond, bar) do { unsigned _sp = 0; while (cond) { __builtin_amdgcn_s_sleep(1); \
    if ((++_sp & 255u) == 0u) { if (xb_ld(&(bar)[XB_TMO])) break; if (_sp > XB_SPIN_CAP) { atomicAdd(&(bar)[XB_TMO], 1u); break; } } } } while (0)
struct XcdBarrier { unsigned* bar; unsigned x; volatile LAS unsigned* st; };
__device__ __forceinline__ XcdBarrier xcd_barrier_post(unsigned* bar, volatile LAS unsigned* st) {
    XcdBarrier b; b.bar = bar; b.x = xb_xcc_id(); b.st = st;
    if (threadIdx.x == 0) (void)xb_add(&bar[XB_XCNT(b.x)], 1u);
    return b;
}
__device__ __forceinline__ void xcd_barrier_complete(unsigned* bar, unsigned x, unsigned& nloc, unsigned& nx) {
    const unsigned G = gridDim.x * gridDim.y * gridDim.z;
    unsigned sum, cnt, mine, sp = 0u;
    for (;;) {
        sum = 0u; cnt = 0u; mine = 0u;
#pragma unroll
        for (unsigned j = 0; j < 16; ++j) { const unsigned c = xb_ld(&bar[XB_XCNT(j)]); sum += c; cnt += (c > 0u) ? 1u : 0u; mine = (j == x) ? c : mine; }
        if (sum == G) break;
        __builtin_amdgcn_s_sleep(1);
        if ((++sp & 255u) == 0u) { if (xb_ld(&bar[XB_TMO])) break; if (sp > XB_SPIN_CAP) { atomicAdd(&bar[XB_TMO], 1u); break; } }
    }
    nloc = mine > 0u ? mine : 1u; nx = cnt > 0u ? cnt : 1u;
}
__device__ __forceinline__ void xcd_census(const XcdBarrier& b) {
    const int tid_c = otid();
    if (tid_c < 64) {
        const unsigned lane = (unsigned)tid_c, G = gridDim.x * gridDim.y * gridDim.z;
        unsigned c = 0u, sum = 0u, sp = 0u;
        for (;;) {
            c = (lane < 16u) ? xb_ld(&b.bar[XB_XCNT(lane)]) : 0u;
            sum = c;
#pragma unroll
            for (int o = 32; o >= 1; o >>= 1) sum += __shfl_xor(sum, o);
            if (sum == G) break;
            __builtin_amdgcn_s_sleep(1);
            if ((++sp & 255u) == 0u) { if (xb_ld(&b.bar[XB_TMO])) break; if (sp > XB_SPIN_CAP) { if (lane == 0) atomicAdd(&b.bar[XB_TMO], 1u); break; } }
        }
        const unsigned cnt = (unsigned)__builtin_popcountll(__ballot(c > 0u));
        const unsigned mine = (unsigned)__shfl((int)c, (int)b.x);
        if (lane == 0) { b.st[0] = mine > 0u ? mine : 1u; b.st[1] = cnt > 0u ? cnt : 1u; }
    }
}
__device__ __forceinline__ void xcd_barrier(const XcdBarrier& b) {
    asm volatile("s_waitcnt vmcnt(0)" ::: "memory");
    __syncthreads();
    if (threadIdx.x == 0) {
        unsigned* bar = b.bar;
        __builtin_amdgcn_s_waitcnt(0);
        unsigned nloc = b.st[0], nx = b.st[1];
        if (nloc == 0u) { xcd_barrier_complete(bar, b.x, nloc, nx); b.st[0] = nloc; b.st[1] = nx; }
        const unsigned old = xb_add(&bar[XB_XSUB(b.x)], 1u);
        const unsigned gen = old / nloc;
        if (old + 1u == (gen + 1u) * nloc) {
            __builtin_amdgcn_fence(__ATOMIC_RELEASE, "agent");
            asm volatile("s_waitcnt vmcnt(0)" ::: "memory");
            const unsigned og = xb_add(&bar[XB_TOP], 1u);
            const unsigned tg = og / nx;
            if (og + 1u == (tg + 1u) * nx) xb_add(&bar[XB_TOPGEN], 1u);
            else XB_SPIN(xb_ld(&bar[XB_TOPGEN]) == tg, bar);
            __builtin_amdgcn_fence(__ATOMIC_ACQUIRE, "agent");
            xb_add(&bar[XB_XGEN(b.x)], 1u);
            asm volatile("s_waitcnt vmcnt(0)" ::: "memory");
        } else {
            XB_SPIN(xb_ld(&bar[XB_XGEN(b.x)]) == gen, bar);
            __builtin_amdgcn_fence(__ATOMIC_ACQUIRE, "agent");
            asm volatile("s_waitcnt vmcnt(0)" ::: "memory");
        }
    }
    __syncthreads();
}


struct CvtSeg { int in_idx, gain_idx, ldsrc, K, dsel, src0, dst0, len; };
__constant__ CvtSeg kSegs[25] = {
    {4, 3, 9232, 2048, 0, 0, 0, 6144}, {4, 3, 9232, 2048, 0, 6144, 9216, 16}, {4, 3, 9232, 2048, 0, 6160, 6144, 512}, {4, 3, 9232, 2048, 0, 6672, 6656, 2560},
    {8, -1, 2048, 2560, 1, 0, 0, 2048},
    {7, 6, 1024, 2048, 2, 0, 0, 1024}, {12, 11, 1024, 2048, 2, 0, 1024, 1024}, {17, 16, 1024, 2048, 2, 0, 2048, 1024}, {26, 25, 1024, 2048, 2, 0, 3072, 1024},
    {22, 21, 3072, 512, 3, 0, 0, 3072}, {24, 23, 4096, 512, 4, 0, 0, 4096},
    {10, 9, 6480, 2048, 0, 0, 0, 2304}, {10, 9, 6480, 2048, 0, 2304, 2304, 1024}, {10, 9, 6480, 2048, 0, 3328, 6400, 64}, {10, 9, 6480, 2048, 0, 3392, 6528, 16},
    {10, 9, 6480, 2048, 0, 3408, 3328, 512}, {10, 9, 6480, 2048, 0, 3920, 3840, 2560}, {13, -1, 2048, 2560, 1, 0, 0, 2048},
    {15, 14, 8704, 2048, 0, 0, 0, 8704}, {18, -1, 2048, 1280, 1, 0, 0, 2048},
    {20, 19, 4160, 2048, 0, 0, 0, 1024}, {20, 19, 4160, 2048, 0, 1024, 4096, 64}, {20, 19, 4160, 2048, 0, 1088, 1024, 512}, {20, 19, 4160, 2048, 0, 1600, 1536, 2560},
    {27, -1, 2048, 2560, 1, 0, 0, 2048}};
__device__ __forceinline__ size_t seg_doff(const CvtSeg& sg, int si) {
    const int par = (si >= 20) ? 1 : (si >= 18 ? 0 : (si >= 11 ? 1 : 0));
    return (sg.dsel == 0) ? WS_WT_IN + par * WT_IN_BYTES : (sg.dsel == 1 ? WS_WT_OUT + par * WT_OUT_BYTES : (sg.dsel == 2 ? WS_WT_MKV : (sg.dsel == 3 ? WS_WT_UQ : WS_WT_UKV)));
}

__global__ void __launch_bounds__(512, 2) fwd_mega(Params p) {
    extern __shared__ __attribute__((aligned(16))) unsigned char lds_raw[];
    LAS unsigned char* L = (LAS unsigned char*)lds_raw;
    cg::grid_group grid = cg::this_grid();
    const int G = gridDim.x, bid = blockIdx.x;
#define WT_IN ((bf16_t*)(p.ws + WS_WT_IN))
#define WT_OUT ((bf16_t*)(p.ws + WS_WT_OUT))
#define WT_UQ ((bf16_t*)(p.ws + WS_WT_UQ))
#define WT_UKV ((bf16_t*)(p.ws + WS_WT_UKV))
#define WT_MKV ((bf16_t*)(p.ws + WS_WT_MKV))
#define HG ((bf16_t*)(p.ws + WS_HG))
#define U ((bf16_t*)(p.ws + WS_U))
#define Q3 ((bf16_t*)(p.ws + WS_Q3))
#define KV3 ((bf16_t*)(p.ws + WS_KV3))
#define MEMN ((bf16_t*)(p.ws + WS_MEMN))
#define MKV ((bf16_t*)(p.ws + WS_MKV))
#define CQ ((bf16_t*)(p.ws + WS_CQ))
#define CKV ((bf16_t*)(p.ws + WS_CKV))
#define MASK ((unsigned*)(p.ws + WS_MASK))
#define CS128 ((float2*)(p.ws + WS_CS128))
#define CS64 ((float2*)(p.ws + WS_CS64))
#define HB ((bf16_t*)(p.ws + WS_HB))
#define SSQ ((float*)(p.ws + WS_SSQ))
    LAS float* T = (LAS float*)L;
    float* xb = p.out;
    volatile LAS unsigned* xst = (volatile LAS unsigned*)(L + LDS_BYTES - 16);
    if (threadIdx.x == 0) { xst[0] = 0u; xst[1] = 0u; xst[2] = 0u; xst[3] = 0u; }
    __syncthreads();
    const XcdBarrier xbar = xcd_barrier_post((unsigned*)(p.ws + WS_BAR), xst);
    if (p.out == nullptr) grid.sync();

    for (int l = 0; l < 4; ++l) {
        if (l == 0) {
            for (int rep = 0; rep < REP_PREP; ++rep) {
                int base = 0;
                for (int si = 0; si < 18; ++si) {
                    if (G == 256 && (si == 4 || si == 9 || si == 10 || si == 17)) continue;
                    const CvtSeg sg = kSegs[si];
                    const size_t doff = seg_doff(sg, si);
                    base = cvt_seg(p.in[sg.in_idx], sg.ldsrc, sg.K, sg.gain_idx >= 0 ? p.in[sg.gain_idx] : nullptr, (bf16_t*)(p.ws + doff), sg.src0, sg.dst0, sg.len, base, T, bid, G);
                }
                rope_tables((const int*)p.in[2], CS128, CS64);
                norm_rows(p.in[1], MEMN, 1024);
                norm_rows(p.in[0], HG, NTOK);
            }
            xcd_census(xbar);
            GSYNC();
        }
        {
            const int npad = (l == 0) ? 9472 : (l == 1 ? 6656 : (l == 2 ? 8704 : 4352));
            const int njobs = (l == 0) ? 2 : 1;
            for (int job = 0; job < njobs * REP_GEMM; ++job) {
                pg8::Gemm g; pg8::EpiBf16 E; pg8::StaticOrder S;
                if (job % njobs == 0) { const int ncols = (l == 3) ? 4096 : npad; g.A = (l == 0) ? HG : HB; g.Bt = WT_IN + (size_t)(l & 1) * (WT_IN_BYTES / 2); g.M = NTOK; g.N = ncols; g.K = 2048; E.O = U; E.ldc = npad; E.ssq = (l == 0) ? nullptr : SSQ; S.init(NTOK, ncols, G, bid); }
                else { g.A = MEMN; g.Bt = WT_MKV; g.M = 1024; g.N = 4096; g.K = 2048; E.O = MKV; E.ldc = 4096; E.ssq = nullptr; S.init(1024, 4096, G, (bid + 64) % G); }
                pg8::gemm_phase<pg8::EpiBf16>(L, g, S, E);
            }
            if (l == 3) krope_gemm(L, HB, WT_IN + (size_t)(l & 1) * (WT_IN_BYTES / 2) + (size_t)4096 * 2048, SSQ, U);
            if (G == 256 && l < 3) {
                const int vb0 = (l == 0) ? 160 : 64, nvb = (l == 0) ? 32 : 192;
                if (bid >= vb0 && bid < vb0 + nvb) {
                    int base = 0;
                    for (int part = 0; part < 2; ++part) {
                        const int lo = part ? ((l == 2) ? 9 : 0) : ((l == 0) ? 17 : (l == 1 ? 18 : 20)), hi2 = part ? ((l == 2) ? 11 : 0) : ((l == 0) ? 18 : (l == 1 ? 20 : 25));
                        for (int si = lo; si < hi2; ++si) {
                            const CvtSeg sg = kSegs[si];
                            base = cvt_seg(p.in[sg.in_idx], sg.ldsrc, sg.K, sg.gain_idx >= 0 ? p.in[sg.gain_idx] : nullptr, (bf16_t*)(p.ws + seg_doff(sg, si)), sg.src0, sg.dst0, sg.len, base, T, bid - vb0, nvb);
                        }
                    }
                }
            }
        }
        GSYNC();
        if (l == 1) { fix_l1(U, CS128, CS64); GSYNC(); for (int rep = 0; rep < REP_IDX; ++rep) phase_indexer(U, CS64, MASK); GSYNC(); }
        if (l == 2) { fix_l2(U, CS128); GSYNC(); }
        if (l == 3) {
            fix_l3(U, CQ, CKV, CS64); GSYNC();
            for (int job = 0; job < 2 * REP_UQ; ++job) {
                pg8::Gemm g; pg8::EpiBf16 E; pg8::StaticOrder S;
                E.ssq = nullptr;
                if ((job & 1) == 0) { g.A = CQ; g.Bt = WT_UQ; g.M = NTOK; g.N = 3072; g.K = 512; E.O = Q3; E.ldc = 3072; S.init(NTOK, 3072, G, bid); }
                else { g.A = CKV; g.Bt = WT_UKV; g.M = NTOK; g.N = 4096; g.K = 512; E.O = KV3; E.ldc = 4096; S.init(NTOK, 4096, G, bid); }
                pg8::gemm_phase<pg8::EpiBf16>(L, g, S, E);
            }
            if (G == 256 && bid >= 128) mem_items(L, bid - 128, G, U, 4352, 1024, 1536 + 2048, MKV, 3, HG, 2560, 2048);
            GSYNC();
        }
        for (int rep = 0; rep < ((l == REP_ATTN_L) ? 2 : REP_ATTN); ++rep) {
            const int ldu = (l == 0) ? 9472 : (l == 1 ? 6656 : (l == 2 ? 8704 : 4352));
            const int qcol = (l == 0) ? 6144 : (l == 1 ? 3328 : (l == 2 ? 6912 : 1024));
            const int zcol = (l == 0) ? 6656 + 2048 : (l == 1 ? 3840 + 2048 : (l == 2 ? 7424 + 768 : 1536 + 2048));
            const int nmain = (l == 2) ? 192 : 256;
            { const int i = bid * 512 + otid(); if (i < NTOK) SSQ[i] = 0.f; }
            {
                const bool slot0 = (G == 256 && l == 0 && bid >= 128), fb = (G != 256 && (l == 1 || l == 2));
                if (rep == 0 && (slot0 || fb)) {
                    int base = 0; const int lo = slot0 ? 4 : (l == 1 ? 18 : 20), hi2 = slot0 ? 5 : (l == 1 ? 20 : 25);
                    for (int si = lo; si < hi2; ++si) { const CvtSeg sg = kSegs[si];
                        base = cvt_seg(p.in[sg.in_idx], sg.ldsrc, sg.K, sg.gain_idx >= 0 ? p.in[sg.gain_idx] : nullptr, (bf16_t*)(p.ws + seg_doff(sg, si)), sg.src0, sg.dst0, sg.len, base, T, slot0 ? bid - 128 : bid, slot0 ? 128 : G); } }
            }
            const int xr = bid & 7, xs = bid >> 3;
            const int itc = (G == 256) ? xr * 32 + xs : bid;
            int itd = bid, itm = bid;
            if (G == 256) { itd = (xs < 24) ? (((xs >> 3) * 8 + xr) * 8 + (xs & 7)) : 192; itm = (l == 2) ? ((xs >= 24) ? (xs - 24) * 8 + xr : 128) : bid; }
            if (l == 0) causal_items<K_FOX>(L, itc, p, U, 9472, HG);
            else if (l == 1) causal_items<K_DSA>(L, itc, p, U, 6656, HG);
            else if (l == 2) dilA_items(L, itd, p, U, (float*)(p.ws + WS_WT_IN), (float*)(p.ws + WS_WT_IN) + (size_t)NTOK * 768);
            else causal_items<K_MLA>(L, itc, p, U, 4352, HG);
            if (!(l == 3 && G == 256))
            mem_items(L, itm, (l == 2 && G == 256) ? 64 : G, U, ldu, qcol, zcol, MKV, l, HG, (l == 2) ? 1280 : 2560, (l == 2) ? 768 : 2048);
        }
        GSYNC();
        if (l == 2) {
            const int xr = bid & 7, xs = bid >> 3; const int itd = (G == 256) ? ((xs < 24) ? (((xs >> 3) * 8 + xr) * 8 + (xs & 7)) : 192) : bid;
            dil_items(L, itd, p, U, HG, (const float*)(p.ws + WS_WT_IN), (const float*)(p.ws + WS_WT_IN) + (size_t)NTOK * 768);
            GSYNC();
        }
        {
            pg8::Gemm g; pg8::EpiResid E; pg8::StaticOrder S;
            g.A = HG; g.Bt = WT_OUT + (size_t)(l & 1) * (WT_OUT_BYTES / 2); g.M = NTOK; g.N = 2048; g.K = (l == 2) ? 1280 : 2560;
            E.xin = (l == 0) ? p.in[0] : xb; E.xout = xb; E.hout = HB; E.ssq = SSQ; S.init(NTOK, 2048, G, bid);
            pg8::gemm_phase<pg8::EpiResid>(L, g, S, E);
        }
        GSYNC();
    }
    final_norm(xb, p.in[28]);
}

#undef WT_IN
#undef WT_OUT
#undef WT_UQ
#undef WT_UKV
#undef WT_MKV
#undef HG
#undef U
#undef Q3
#undef KV3
#undef MEMN
#undef MKV
#undef CQ
#undef CKV
#undef MASK
#undef CS128
#undef CS64
#undef HB
#undef SSQ

extern "C" void kernel_launch(void* const* d_in, const int* in_sizes, int n_in, void* d_out, int out_size, void* d_ws, size_t ws_size, hipStream_t stream) {
    static int grid = 0;
    if (grid == 0) {
        int dev = 0, cus = 0, per_cu = 0;
        hipGetDevice(&dev);
        hipDeviceGetAttribute(&cus, hipDeviceAttributeMultiprocessorCount, dev);
        hipFuncSetAttribute((const void*)fwd_mega, hipFuncAttributeMaxDynamicSharedMemorySize, LDS_BYTES);
        hipOccupancyMaxActiveBlocksPerMultiprocessor(&per_cu, (const void*)fwd_mega, 512, LDS_BYTES);
        (void)hipGetLastError();
        grid = cus;
        if (ws_size < WS_END || n_in != 29 || cus < 16) { fprintf(stderr, "kernel_launch: ws %zu < %zu or n_in %d != 29\n", ws_size, (size_t)WS_END, n_in); grid = -1; }
    }
    if (grid < 0) return;
    Params p{};
    for (int i = 0; i < n_in && i < 32; ++i) p.in[i] = (const float*)d_in[i];
    p.out = (float*)d_out; p.ws = (unsigned char*)d_ws;
    hipMemsetAsync((unsigned char*)d_ws + WS_BAR, 0, BAR_BYTES, stream);
    void* args[] = {&p};
    hipError_t e = hipLaunchCooperativeKernel((const void*)fwd_mega, dim3(grid), dim3(512), args, LDS_BYTES, stream);
    if (e != hipSuccess) fprintf(stderr, "cooperative launch failed: %s (grid %d)\n", hipGetErrorString(e), grid);
}
```
